# Optimizing an MI355X kernel written in HIP

```python
import math
import jax, jax.numpy as jnp
from jax import lax
import numpy as np

D_MODEL = 2048
BATCH = 4
SEQ = 4096
DEPTH = 2

HEAD_DIM = 128
N_HEADS = 8
N_KV_HEADS = 2
IDX_HEADS = 16
IDX_DIM = 64
MAX_TOPK = 256
Q_BLOCK = 128
CONV_CH = 512
CONV_WIDTH = 31
MEM_LEN = 256
MEM_HEADS = 4
FFN_DIM = 4 * D_MODEL
ROPE_THETA = 500000.0
ROT_FRACTION = 4
N_BRANCH = 3
EPS = 1e-6

ATTN_DIM = N_HEADS * HEAD_DIM
KV_DIM = N_KV_HEADS * HEAD_DIM
MEM_DIM = MEM_HEADS * HEAD_DIM
SPLITS = (ATTN_DIM, KV_DIM, KV_DIM, IDX_HEADS * IDX_DIM, IDX_DIM, IDX_HEADS,
          2 * CONV_CH, MEM_DIM, N_BRANCH * D_MODEL)
N_IN = sum(SPLITS)

kernel_name = "hybrid_dsa_conformer_memory_gated_block"


def rms_norm(x, g):
    xf = x.astype(jnp.float32)
    y = xf * lax.rsqrt(jnp.mean(xf * xf, axis=-1, keepdims=True) + EPS)
    return (y * g.astype(jnp.float32)).astype(x.dtype)


def layer_norm(x, g, b):
    xf = x.astype(jnp.float32)
    mu = jnp.mean(xf, axis=-1, keepdims=True)
    var = jnp.mean(jnp.square(xf - mu), axis=-1, keepdims=True)
    y = (xf - mu) * lax.rsqrt(var + EPS)
    return (y * g.astype(jnp.float32) + b.astype(jnp.float32)).astype(x.dtype)


def rope_tables(positions, rot_dim):
    half = rot_dim // 2
    inv_freq = ROPE_THETA ** (-jnp.arange(half, dtype=jnp.float32) * 2.0 / rot_dim)
    ang = positions.astype(jnp.float32)[..., None] * inv_freq
    return jnp.cos(ang)[:, :, None, :], jnp.sin(ang)[:, :, None, :]


def apply_partial_rope(t, cos, sin):
    half = cos.shape[-1]
    rot = 2 * half
    tf = t.astype(jnp.float32)
    t1, t2, tp = tf[..., :half], tf[..., half:rot], tf[..., rot:]
    out = jnp.concatenate([t1 * cos - t2 * sin, t2 * cos + t1 * sin, tp], axis=-1)
    return out.astype(t.dtype)


def dsa_sparse_attention(q, k, v, iq, ik, iw):
    B, S = q.shape[0], q.shape[1]
    topk = min(MAX_TOPK, S // 4)
    nb = S // Q_BLOCK
    group = N_HEADS // N_KV_HEADS
    scale = HEAD_DIM ** -0.5
    idx_scale = (IDX_DIM ** -0.5) * (IDX_HEADS ** -0.5)
    key_pos = jnp.arange(S, dtype=jnp.int32)
    starts = jnp.arange(nb, dtype=jnp.int32) * Q_BLOCK
    gather = jax.vmap(lambda t, i: t[i])

    def to_blocks(t):
        return t.reshape((B, nb, Q_BLOCK) + t.shape[2:]).swapaxes(0, 1)

    def block(args):
        qb, iqb, iwb, t0 = args
        s_idx = jnp.einsum('bqhd,bsd->bqhs', iqb, ik).astype(jnp.float32)
        index = jnp.einsum('bqh,bqhs->bqs', iwb.astype(jnp.float32),
                           jax.nn.relu(s_idx)) * idx_scale
        q_pos = t0 + jnp.arange(Q_BLOCK, dtype=jnp.int32)
        causal = key_pos[None, :] <= q_pos[:, None]
        index = jnp.where(causal[None], index, -jnp.inf)
        sel_val, sel_idx = lax.top_k(index, topk)
        valid = jnp.isfinite(sel_val)
        k_sel = gather(k, sel_idx)
        v_sel = gather(v, sel_idx)
        qg = qb.reshape(B, Q_BLOCK, N_KV_HEADS, group, HEAD_DIM)
        logits = jnp.einsum('bqkgd,bqnkd->bqkgn', qg, k_sel).astype(jnp.float32) * scale
        logits = jnp.where(valid[:, :, None, None, :], logits, -jnp.inf)
        p = jax.nn.softmax(logits, axis=-1).astype(v.dtype)
        o = jnp.einsum('bqkgn,bqnkd->bqkgd', p, v_sel)
        return o.reshape(B, Q_BLOCK, N_HEADS * HEAD_DIM)

    out = lax.map(block, (to_blocks(q), to_blocks(iq), to_blocks(iw), starts))
    return out.swapaxes(0, 1).reshape(B, S, N_HEADS * HEAD_DIM)


def memory_cross_attention(q, mk, mv):
    B, S = q.shape[0], q.shape[1]
    logits = jnp.einsum('bshd,bmhd->bhsm', q, mk).astype(jnp.float32) * (HEAD_DIM ** -0.5)
    p = jax.nn.softmax(logits, axis=-1).astype(mv.dtype)
    o = jnp.einsum('bhsm,bmhd->bshd', p, mv)
    return o.reshape(B, S, MEM_HEADS * HEAD_DIM)


def conformer_conv(glu_in, conv_in_b, conv_w, conv_b, ln_g, ln_b):
    a, gte = jnp.split(glu_in + conv_in_b, 2, axis=-1)
    u = a * jax.nn.sigmoid(gte)
    y = lax.conv_general_dilated(
        u, conv_w[:, None, :].astype(u.dtype), window_strides=(1,),
        padding=[(CONV_WIDTH - 1, 0)],
        dimension_numbers=('NWC', 'WIO', 'NWC'),
        feature_group_count=CONV_CH) + conv_b
    y = layer_norm(y, ln_g, ln_b)
    return jax.nn.silu(y)


def setup_inputs(seed: int = 0) -> dict:
    key = jax.random.key(seed)
    ks = jax.random.split(key, 32)

    def nrm(k, shape, fan_in, extra=1.0):
        return jax.random.normal(k, shape, jnp.float32) * (fan_in ** -0.5) * extra

    def gain(k, shape):
        return 1.0 + 0.1 * jax.random.normal(k, shape, jnp.float32)

    def bias(k, shape):
        return 0.02 * jax.random.normal(k, shape, jnp.float32)

    res_scale = (2 * DEPTH) ** -0.5
    x = jax.random.normal(ks[0], (BATCH, SEQ, D_MODEL), jnp.float32)
    mem = jax.random.normal(ks[1], (BATCH, MEM_LEN, D_MODEL), jnp.float32)
    offsets = jax.random.randint(ks[2], (BATCH, 1), 0, 1024, dtype=jnp.int32)
    positions = offsets + jnp.arange(SEQ, dtype=jnp.int32)[None, :]
    return {
        "x": x,
        "mem": mem,
        "positions": positions,
        "norm1_g": gain(ks[3], (DEPTH, D_MODEL)),
        "w_in": nrm(ks[4], (DEPTH, D_MODEL, N_IN), D_MODEL),
        "q_norm_g": gain(ks[5], (DEPTH, HEAD_DIM)),
        "k_norm_g": gain(ks[6], (DEPTH, HEAD_DIM)),
        "mem_norm_g": gain(ks[7], (DEPTH, D_MODEL)),
        "w_mem_kv": nrm(ks[8], (DEPTH, D_MODEL, 2 * MEM_DIM), D_MODEL),
        "mq_norm_g": gain(ks[9], (DEPTH, HEAD_DIM)),
        "mk_norm_g": gain(ks[10], (DEPTH, HEAD_DIM)),
        "conv_in_b": bias(ks[11], (DEPTH, 2 * CONV_CH)),
        "conv_w": nrm(ks[12], (DEPTH, CONV_WIDTH, CONV_CH), CONV_WIDTH),
        "conv_b": bias(ks[13], (DEPTH, CONV_CH)),
        "conv_ln_g": gain(ks[14], (DEPTH, CONV_CH)),
        "conv_ln_b": bias(ks[15], (DEPTH, CONV_CH)),
        "gate_b": bias(ks[16], (DEPTH, N_BRANCH * D_MODEL)),
        "w_attn_o": nrm(ks[17], (DEPTH, ATTN_DIM, D_MODEL), ATTN_DIM),
        "w_mem_o": nrm(ks[18], (DEPTH, MEM_DIM, D_MODEL), MEM_DIM),
        "w_conv_o": nrm(ks[19], (DEPTH, CONV_CH, D_MODEL), CONV_CH),
        "conv_o_b": bias(ks[20], (DEPTH, D_MODEL)),
        "w_out": nrm(ks[21], (DEPTH, D_MODEL, D_MODEL), D_MODEL, res_scale),
        "norm2_g": gain(ks[22], (DEPTH, D_MODEL)),
        "w_up": nrm(ks[23], (DEPTH, D_MODEL, FFN_DIM), D_MODEL),
        "w_down": nrm(ks[24], (DEPTH, FFN_DIM, D_MODEL), FFN_DIM, res_scale),
    }


def reference(x, mem, positions, norm1_g, w_in, q_norm_g, k_norm_g, mem_norm_g,
              w_mem_kv, mq_norm_g, mk_norm_g, conv_in_b, conv_w, conv_b,
              conv_ln_g, conv_ln_b, gate_b, w_attn_o, w_mem_o, w_conv_o,
              conv_o_b, w_out, norm2_g, w_up, w_down):
    B, S, _ = x.shape
    M = mem.shape[1]
    cos_h, sin_h = rope_tables(positions, HEAD_DIM // ROT_FRACTION)
    cos_i, sin_i = rope_tables(positions, IDX_DIM // ROT_FRACTION)
    bounds = np.cumsum(SPLITS)[:-1].tolist()

    for l in range(DEPTH):
        h = rms_norm(x, norm1_g[l])
        proj = h @ w_in[l]
        q, k, v, iq, ik, iw, glu_in, mq, gates = jnp.split(proj, bounds, axis=-1)

        q = apply_partial_rope(rms_norm(q.reshape(B, S, N_HEADS, HEAD_DIM), q_norm_g[l]), cos_h, sin_h)
        k = apply_partial_rope(rms_norm(k.reshape(B, S, N_KV_HEADS, HEAD_DIM), k_norm_g[l]), cos_h, sin_h)
        v = v.reshape(B, S, N_KV_HEADS, HEAD_DIM)
        iq = apply_partial_rope(iq.reshape(B, S, IDX_HEADS, IDX_DIM), cos_i, sin_i)
        ik = apply_partial_rope(ik[:, :, None, :], cos_i, sin_i)[:, :, 0, :]
        y_attn = dsa_sparse_attention(q, k, v, iq, ik, iw) @ w_attn_o[l]

        m = rms_norm(mem, mem_norm_g[l])
        mkv = (m @ w_mem_kv[l]).reshape(B, M, 2, MEM_HEADS, HEAD_DIM)
        mk = rms_norm(mkv[:, :, 0], mk_norm_g[l])
        mv = mkv[:, :, 1]
        mq = rms_norm(mq.reshape(B, S, MEM_HEADS, HEAD_DIM), mq_norm_g[l])
        y_mem = memory_cross_attention(mq, mk, mv) @ w_mem_o[l]

        y_conv = conformer_conv(glu_in, conv_in_b[l], conv_w[l], conv_b[l],
                                conv_ln_g[l], conv_ln_b[l]) @ w_conv_o[l] + conv_o_b[l]

        g = jax.nn.sigmoid(gates + gate_b[l]).reshape(B, S, N_BRANCH, D_MODEL)
        merged = g[:, :, 0] * y_attn + g[:, :, 1] * y_mem + g[:, :, 2] * y_conv
        x = x + merged @ w_out[l]

        h2 = rms_norm(x, norm2_g[l])
        x = x + jnp.square(jax.nn.relu(h2 @ w_up[l])) @ w_down[l]
    return x
```

```cpp
#include <hip/hip_runtime.h>
#include <hip/hip_cooperative_groups.h>
#include <cstdio>
namespace cg = cooperative_groups;

#define LAS __attribute__((address_space(3)))
#define DI __device__ __forceinline__
typedef unsigned short bf16_t;
typedef short bf16x8 __attribute__((ext_vector_type(8)));
typedef short s16x4 __attribute__((ext_vector_type(4)));
typedef float f32x4 __attribute__((ext_vector_type(4)));
typedef float f32x2 __attribute__((ext_vector_type(2)));
typedef float f32x16 __attribute__((ext_vector_type(16)));
typedef unsigned u32x4 __attribute__((ext_vector_type(4)));
typedef unsigned u32x2 __attribute__((ext_vector_type(2)));
typedef __bf16 bf16x2_t __attribute__((ext_vector_type(2)));

constexpr int NB = 4, S_ = 4096, T_ = NB * S_, D_ = 2048, FF_ = 8192;
constexpr int NIN = 10320, NPAD = 10496, NPROJ = 4352, NGATE = 6144;
constexpr int MEMROWS = NB * 256;
constexpr int A_ROWS = T_ + MEMROWS;
constexpr int BT_ROWS = NPAD + 1024;
constexpr float EPS_ = 1e-6f;
constexpr int PC_Q = 0, PC_K = 1024, PC_V = 1280, PC_IQ = 1536, PC_IK = 2560, PC_IW = 2624, PC_GLU = 2816, PC_MQ = 3840;

constexpr size_t WS_WT_IN = 0;
constexpr size_t WS_WT_AO = WS_WT_IN + (size_t)BT_ROWS * 2048 * 2;
constexpr size_t WS_WT_MO = WS_WT_AO + (size_t)2048 * 1024 * 2;
constexpr size_t WS_WT_CO = WS_WT_MO + (size_t)2048 * 512 * 2;
constexpr size_t WS_WT_OUT = WS_WT_CO + (size_t)2048 * 512 * 2;
constexpr size_t WS_WT_UP = WS_WT_OUT + (size_t)2048 * 2048 * 2;
constexpr size_t WS_WT_DN = WS_WT_UP + (size_t)8192 * 2048 * 2;
constexpr size_t WS_G = WS_WT_DN + (size_t)2048 * 8192 * 2;
constexpr size_t WS_P = WS_G + (size_t)T_ * NGATE * 2;
constexpr size_t WS_HID = WS_G;
constexpr size_t WS_OA = WS_P, WS_OM = WS_OA + (size_t)T_ * 1024 * 2, WS_CC = WS_OM + (size_t)T_ * 512 * 2;
constexpr size_t WS_A = WS_P + (size_t)T_ * NPROJ * 2;
constexpr size_t WS_Q = WS_A, WS_IQ = WS_A + (size_t)T_ * 1024 * 2;
constexpr size_t WS_MERGED = WS_A;
constexpr size_t WS_K = WS_A + (size_t)A_ROWS * 2048 * 2;
constexpr size_t WS_VT = WS_K + (size_t)T_ * 256 * 2;
constexpr size_t WS_IK = WS_VT + (size_t)T_ * 256 * 2;
constexpr size_t WS_IW = WS_IK + (size_t)T_ * 64 * 2;
constexpr size_t WS_U = WS_IW + (size_t)T_ * 16 * 4;
constexpr size_t WS_MQ = WS_U + (size_t)T_ * 512 * 2;
constexpr size_t WS_MK = WS_MQ + (size_t)T_ * 512 * 2;
constexpr size_t WS_MVT = WS_MK + (size_t)MEMROWS * 512 * 2;
constexpr size_t WS_MASK = WS_MVT + (size_t)MEMROWS * 512 * 2;
constexpr size_t WS_MKV = WS_MASK + (size_t)NB * 64 * S_ * 8;
constexpr size_t WS_CTL = WS_MKV + (size_t)MEMROWS * 1024 * 2;
constexpr size_t CTL_BYTES = 16384;
constexpr size_t WS_END = WS_CTL + CTL_BYTES;
static_assert(WS_HID + (size_t)T_ * FF_ * 2 <= WS_A, "hidden overlay");
static_assert(WS_CC + (size_t)T_ * 512 * 2 <= WS_A, "branch outputs inside P");
static_assert(WS_IQ + (size_t)T_ * 1024 * 2 <= WS_K, "q/iq inside A");
static_assert(WS_END <= 676331520ull, "workspace");

constexpr int LDS_BYTES = 147456;
#ifndef REP3A
#define REP3A 1
#endif
#ifndef REP3C
#define REP3C 1
#endif
#ifndef REP1
#define REP1 1
#endif
#ifndef REP8
#define REP8 1
#endif
#ifndef REP5
#define REP5 1
#endif
#ifndef REP0
#define REP0 1
#endif
#ifndef REP2
#define REP2 1
#endif
#ifndef REP3
#define REP3 1
#endif
#ifndef REP4
#define REP4 1
#endif
#ifndef REP7
#define REP7 1
#endif

DI int fresh_tid() { int t = threadIdx.x; asm volatile("" : "+v"(t)); return t; }
DI float bf2f(unsigned short b) { return __uint_as_float(((unsigned)b) << 16); }
DI unsigned pk2(float lo, float hi) { f32x2 v = {lo, hi}; bf16x2_t b = __builtin_convertvector(v, bf16x2_t); return __builtin_bit_cast(unsigned, b); }
DI float wave_sum(float v) {
#pragma unroll
    for (int o = 1; o < 64; o <<= 1) v += __shfl_xor(v, o);
    return v;
}
DI float wave_max(float v) {
#pragma unroll
    for (int o = 1; o < 64; o <<= 1) v = fmaxf(v, __shfl_xor(v, o));
    return v;
}
DI void unpack8(u32x4 w, float* v) {
    v[0] = __uint_as_float(w.x << 16); v[1] = __uint_as_float(w.x & 0xffff0000u);
    v[2] = __uint_as_float(w.y << 16); v[3] = __uint_as_float(w.y & 0xffff0000u);
    v[4] = __uint_as_float(w.z << 16); v[5] = __uint_as_float(w.z & 0xffff0000u);
    v[6] = __uint_as_float(w.w << 16); v[7] = __uint_as_float(w.w & 0xffff0000u);
}
DI u32x4 pack8(const float* v) { u32x4 w; w.x = pk2(v[0], v[1]); w.y = pk2(v[2], v[3]); w.z = pk2(v[4], v[5]); w.w = pk2(v[6], v[7]); return w; }
DI unsigned pack_gate4(float a, float b, float c, float d) {
    unsigned w = 0u;
    w = __builtin_amdgcn_cvt_pk_u8_f32(fmaxf(a * 255.f, 1.f), 0, w); w = __builtin_amdgcn_cvt_pk_u8_f32(fmaxf(b * 255.f, 1.f), 1, w);
    w = __builtin_amdgcn_cvt_pk_u8_f32(fmaxf(c * 255.f, 1.f), 2, w); w = __builtin_amdgcn_cvt_pk_u8_f32(fmaxf(d * 255.f, 1.f), 3, w);
    return w;
}
DI void unpack_gate8(u32x2 w, float* v) {
    v[0] = (float)(w.x & 0xffu); v[1] = (float)((w.x >> 8) & 0xffu); v[2] = (float)((w.x >> 16) & 0xffu); v[3] = (float)(w.x >> 24);
    v[4] = (float)(w.y & 0xffu); v[5] = (float)((w.y >> 8) & 0xffu); v[6] = (float)((w.y >> 16) & 0xffu); v[7] = (float)(w.y >> 24);
}
DI float sigmoidf_(float x) { return __builtin_amdgcn_rcpf(1.0f + __builtin_amdgcn_exp2f(x * -1.4426950408889634f)); }

namespace pg8 {
constexpr int BM = 256, BK = 64, HALF = 128, HTB = HALF * BK * 2, STAGE_BYTES = 8 * HTB, NXCD = 8, WGM = 4;
DI int lds_byte(int r, int c) { const int st = (r >> 4) * 2 + (c >> 5), rr = r & 15, cc = c & 31, ob = rr * 64 + cc * 2; return st * 1024 + (ob ^ (((ob >> 9) & 1) << 5)); }
DI void stage_rc(int b, int& R, int& C) { const int st = b / 1024, sb = b % 1024, swz = sb ^ (((sb >> 9) & 1) << 5); R = (st >> 1) * 16 + swz / 64; C = (st & 1) * 32 + (swz % 64) / 2; }
DI int perm32(int rho) { const int n = rho >> 4, i = rho & 15; return 8 * (i >> 2) + 4 * n + (i & 3); }
struct Unit { int pm, pn; };
struct Gemm { const bf16_t* A; const bf16_t* Bt; int K; };
DI void static_map(int wgid, int nM, int nN, Unit& u) {
    const int nwg = nM * nN;
    { const int q = nwg / NXCD, r = nwg % NXCD, xcd = wgid % NXCD, off = wgid / NXCD; wgid = (xcd < r ? xcd * (q + 1) : r * (q + 1) + (xcd - r) * q) + off; }
    const int nig = WGM * nN, gid = wgid / nig, fm = gid * WGM, gsz = (nM - fm) < WGM ? (nM - fm) : WGM;
    u.pm = fm + ((wgid % nig) % gsz); u.pn = (wgid % nig) / gsz;
}
struct StaticOrder {
    int nM, nN, nwg, G, c;
    DI void init(int M, int N, int G_, int c_) { nM = M / BM; nN = N / BM; nwg = nM * nN; G = G_; c = c_; }
    DI bool next(int i, Unit& u) const { const long L = (long)i * G + c; if (L >= nwg) return false; static_map((int)L, nM, nN, u); return true; }
};
struct InOrder {
    int G, c;
    DI bool next(int i, Unit& u) const {
        const long L = (long)i * G + c;
        if (L < 2624) { static_map((int)L, 64, 41, u); return true; }
        if (L < 2640) { const int e = (int)L - 2624; u.pm = 64 + (e >> 2); u.pn = 41 + (e & 3); return true; }
        return false;
    }
};

template <class Epi, class Sched>
DI void gemm_phase(LAS unsigned char* lds, const Gemm g, const Sched& S, const Epi& E) {
    const int tid = fresh_tid(), wid = __builtin_amdgcn_readfirstlane(tid >> 6), lane = tid & 63, wr = wid >> 2, wc = wid & 3, fr = lane & 15, fq = lane >> 4;
    const int K = g.K, nt = K / BK;
    unsigned voffA[2], voffB[2];
#pragma unroll
    for (int i = 0; i < 2; ++i) { int R, C; stage_rc(tid * 16 + i * 8192, R, C); const int Rb = (R & ~31) + perm32(R & 31);
        voffA[i] = (unsigned)(R * K + C) * 2u; voffB[i] = (unsigned)(Rb * K + C) * 2u; }
    const size_t kstep = (size_t)(BK * 2);
    const size_t hstep = (size_t)HALF * K * 2;
    const size_t tstep = 2 * hstep;
    const unsigned ldsw = (unsigned)wid * 1024u;
    const int aoff = lds_byte(wr * 64 + fr, fq * 8), boff = lds_byte(wc * 32 + fr, fq * 8);
#define PG8_SA(b, h) (((b) * 2 + (h)) * HTB)
#define PG8_SB(b, h) ((4 + (b) * 2 + (h)) * HTB)
#define PG8_STAGE(bufoff, gbase, voff) do { _Pragma("unroll") for (int _i = 0; _i < 2; ++_i) \
        __builtin_amdgcn_global_load_lds((const unsigned*)((const char*)(gbase) + (voff)[_i]), (LAS unsigned*)(lds + (bufoff) + ldsw + _i * 8192), 16, 0, 0); } while (0)
#define PG8_LDA(dst, b, h) do { _Pragma("unroll") for (int m = 0; m < 4; ++m) _Pragma("unroll") for (int k = 0; k < 2; ++k) dst[m][k] = *(const LAS bf16x8*)(lds + PG8_SA(b, h) + aoff + m * 2048 + k * 1024); } while (0)
#define PG8_LDB(dst, b, h) do { _Pragma("unroll") for (int n = 0; n < 2; ++n) _Pragma("unroll") for (int k = 0; k < 2; ++k) dst[n][k] = *(const LAS bf16x8*)(lds + PG8_SB(b, h) + boff + n * 2048 + k * 1024); } while (0)
#define PG8_MMA(ai, bj, At, Bt) do { __builtin_amdgcn_s_setprio(1); _Pragma("unroll") for (int m = 0; m < 4; ++m) _Pragma("unroll") for (int n = 0; n < 2; ++n) _Pragma("unroll") for (int k = 0; k < 2; ++k) \
        acc[ai][bj][m][n] = __builtin_amdgcn_mfma_f32_16x16x32_bf16(Bt[n][k], At[m][k], acc[ai][bj][m][n], 0, 0, 0); __builtin_amdgcn_s_setprio(0); } while (0)
#define PG8_WAIT_V(n) asm volatile("s_waitcnt vmcnt(" #n ")" ::: "memory")
#define PG8_WAIT_L(n) asm volatile("s_waitcnt lgkmcnt(" #n ")" ::: "memory")
#define PG8_BAR __builtin_amdgcn_s_barrier()
#define PG8_SCHED __builtin_amdgcn_sched_barrier(0)
    Unit cur, nxt; int ui = 0;
    if (!S.next(0, cur)) return;
    f32x4 acc[2][2][4][2];
#pragma unroll
    for (int a = 0; a < 2; ++a)
#pragma unroll
        for (int b = 0; b < 2; ++b)
#pragma unroll
            for (int m = 0; m < 4; ++m)
#pragma unroll
                for (int n = 0; n < 2; ++n) acc[a][b][m][n] = (f32x4){0.f, 0.f, 0.f, 0.f};
    bf16x8 At[4][2], B0[2][2], B1[2][2];
    const char* cA = (const char*)g.A + (size_t)cur.pm * tstep; const char* cB = (const char*)g.Bt + (size_t)cur.pn * tstep;
    PG8_STAGE(PG8_SB(0, 0), cB, voffB); PG8_STAGE(PG8_SA(0, 0), cA, voffA); PG8_STAGE(PG8_SB(0, 1), cB + hstep, voffB); PG8_STAGE(PG8_SA(0, 1), cA + hstep, voffA);
    if (wr == 1) PG8_BAR;
    PG8_WAIT_V(4); PG8_BAR;
    PG8_STAGE(PG8_SB(1, 0), cB + kstep, voffB); PG8_STAGE(PG8_SA(1, 0), cA + kstep, voffA); PG8_STAGE(PG8_SB(1, 1), cB + hstep + kstep, voffB);
    PG8_WAIT_V(6); PG8_BAR;
    for (;;) {
        const bool has_next = S.next(ui + 1, nxt);
        const char* nA = has_next ? (const char*)g.A + (size_t)nxt.pm * tstep : cA; const char* nB = has_next ? (const char*)g.Bt + (size_t)nxt.pn * tstep : cB;
        for (int t = 0; t < nt; t += 2) {
            const bool last = (t == nt - 2);
            const char* a1 = cA + (size_t)(t + 1) * kstep;
            const char* a2 = last ? nA : cA + (size_t)(t + 2) * kstep; const char* b2 = last ? nB : cB + (size_t)(t + 2) * kstep;
            const char* a3 = a2 + kstep; const char* b3 = b2 + kstep;
            PG8_LDB(B0, 0, 0); PG8_SCHED; PG8_LDA(At, 0, 0); PG8_STAGE(PG8_SA(1, 1), a1 + hstep, voffA);
            PG8_WAIT_L(8); PG8_BAR; PG8_WAIT_L(0); PG8_MMA(0, 0, At, B0); PG8_BAR; PG8_SCHED;
            PG8_LDB(B1, 0, 1); PG8_STAGE(PG8_SB(0, 0), b2, voffB);
            PG8_BAR; PG8_WAIT_L(0); PG8_MMA(0, 1, At, B1); PG8_BAR;
            PG8_LDA(At, 0, 1); PG8_STAGE(PG8_SA(0, 0), a2, voffA);
            PG8_BAR; PG8_WAIT_L(0); PG8_MMA(1, 0, At, B0); PG8_BAR; PG8_SCHED;
            PG8_STAGE(PG8_SB(0, 1), b2 + hstep, voffB);
            PG8_WAIT_V(6); PG8_BAR; PG8_MMA(1, 1, At, B1); PG8_BAR;
            PG8_LDB(B0, 1, 0); PG8_SCHED; PG8_LDA(At, 1, 0); PG8_STAGE(PG8_SA(0, 1), a2 + hstep, voffA);
            PG8_WAIT_L(8); PG8_BAR; PG8_WAIT_L(0); PG8_MMA(0, 0, At, B0); PG8_BAR; PG8_SCHED;
            PG8_LDB(B1, 1, 1); PG8_STAGE(PG8_SB(1, 0), b3, voffB);
            PG8_BAR; PG8_WAIT_L(0); PG8_MMA(0, 1, At, B1); PG8_BAR;
            PG8_LDA(At, 1, 1); PG8_STAGE(PG8_SA(1, 0), a3, voffA);
            PG8_BAR; PG8_WAIT_L(0); PG8_MMA(1, 0, At, B0); PG8_BAR; PG8_SCHED;
            PG8_STAGE(PG8_SB(1, 1), b3 + hstep, voffB);
            PG8_WAIT_V(6); PG8_BAR; PG8_MMA(1, 1, At, B1); PG8_BAR;
        }
        E(acc, cur, wr, wc, fr, fq);
        if (!has_next) break;
#pragma unroll
        for (int a = 0; a < 2; ++a)
#pragma unroll
            for (int b = 0; b < 2; ++b)
#pragma unroll
                for (int m = 0; m < 4; ++m)
#pragma unroll
                    for (int n = 0; n < 2; ++n) acc[a][b][m][n] = (f32x4){0.f, 0.f, 0.f, 0.f};
        cur = nxt; cA = nA; cB = nB; ++ui;
    }
    PG8_WAIT_V(0);
    if (wr == 0) PG8_BAR;
    PG8_BAR;
#undef PG8_SA
#undef PG8_SB
#undef PG8_STAGE
#undef PG8_LDA
#undef PG8_LDB
#undef PG8_MMA
#undef PG8_WAIT_V
#undef PG8_WAIT_L
#undef PG8_BAR
#undef PG8_SCHED
}

typedef f32x4 AccT[2][2][4][2];
struct EpiIn {
    bf16_t* P; bf16_t* G; bf16_t* MKV; const float* gate_b;
    DI void operator()(const AccT& acc, const Unit& u, int wr, int wc, int fr, int fq) const {
        const int row0 = u.pm * BM + wr * 64 + fr;
        bf16_t* base; int ldc, colt; bool gate = false;
        if (u.pn >= 41) { base = MKV - (size_t)T_ * 1024; ldc = 1024; colt = (u.pn - 41) * BM; }
        else if (u.pn >= 17) { base = G; ldc = NGATE; colt = (u.pn - 17) * BM; gate = true; }
        else { base = P; ldc = NPROJ; colt = u.pn * BM; }
        const int col0 = colt + wc * 32 + 8 * fq;
        f32x4 bv[2][2];
#pragma unroll
        for (int bj = 0; bj < 2; ++bj)
#pragma unroll
            for (int n = 0; n < 2; ++n) bv[bj][n] = gate ? *(const f32x4*)(gate_b + col0 + bj * HALF + 4 * n) : (f32x4){0.f, 0.f, 0.f, 0.f};
#pragma unroll
        for (int ai = 0; ai < 2; ++ai)
#pragma unroll
            for (int m = 0; m < 4; ++m) { bf16_t* rowp = base + (size_t)(row0 + ai * HALF + m * 16) * ldc + col0;
#pragma unroll
                for (int bj = 0; bj < 2; ++bj) { f32x4 v0 = acc[ai][bj][m][0] + bv[bj][0], v1 = acc[ai][bj][m][1] + bv[bj][1];
                    if (gate) {
#pragma unroll
                        for (int j = 0; j < 4; ++j) { v0[j] = sigmoidf_(v0[j]); v1[j] = sigmoidf_(v1[j]); } }
                    if (gate) {
                        u32x2 q; q.x = pack_gate4(v0[0], v0[1], v0[2], v0[3]); q.y = pack_gate4(v1[0], v1[1], v1[2], v1[3]);
                        *(u32x2*)((unsigned char*)G + (size_t)(row0 + ai * HALF + m * 16) * NGATE + col0 + bj * HALF) = q;
                    } else {
                        u32x4 w; w.x = pk2(v0[0], v0[1]); w.y = pk2(v0[2], v0[3]); w.z = pk2(v1[0], v1[1]); w.w = pk2(v1[2], v1[3]);
                        *(u32x4*)(rowp + bj * HALF) = w; } } }
    }
};
template <int MODE> struct EpiGate {
    bf16_t* Mg; const bf16_t* gate; const float* bias;
    DI void operator()(const AccT& acc, const Unit& u, int wr, int wc, int fr, int fq) const {
        const int row0 = u.pm * BM + wr * 64 + fr, col0 = u.pn * BM + wc * 32 + 8 * fq;
        f32x4 bv[2][2];
#pragma unroll
        for (int bj = 0; bj < 2; ++bj)
#pragma unroll
            for (int n = 0; n < 2; ++n) bv[bj][n] = bias ? *(const f32x4*)(bias + col0 + bj * HALF + 4 * n) : (f32x4){0.f, 0.f, 0.f, 0.f};
#pragma unroll
        for (int ai = 0; ai < 2; ++ai)
#pragma unroll
            for (int m = 0; m < 4; ++m) { const size_t r = (size_t)(row0 + ai * HALF + m * 16);
#pragma unroll
                for (int bj = 0; bj < 2; ++bj) {
                    float gv[8], mv[8], o[8];
                    unpack8(*(const u32x4*)(gate + r * NGATE + col0 + bj * HALF), gv);
                    bf16_t* mp = Mg + r * D_ + col0 + bj * HALF;
                    if (MODE) unpack8(*(const u32x4*)mp, mv);
                    const f32x4 v0 = acc[ai][bj][m][0] + bv[bj][0], v1 = acc[ai][bj][m][1] + bv[bj][1];
#pragma unroll
                    for (int j = 0; j < 4; ++j) { o[j] = gv[j] * v0[j] + (MODE ? mv[j] : 0.f); o[4 + j] = gv[4 + j] * v1[j] + (MODE ? mv[4 + j] : 0.f); }
                    *(u32x4*)mp = pack8(o); } }
    }
};
struct EpiRes {
    const float* res; float* out;
    DI void operator()(const AccT& acc, const Unit& u, int wr, int wc, int fr, int fq) const {
        const int row0 = u.pm * BM + wr * 64 + fr, col0 = u.pn * BM + wc * 32 + 8 * fq;
#pragma unroll
        for (int ai = 0; ai < 2; ++ai)
#pragma unroll
            for (int mh = 0; mh < 2; ++mh) {
                f32x4 r[2][2][2];
#pragma unroll
                for (int mm = 0; mm < 2; ++mm) { const size_t off = (size_t)(row0 + ai * HALF + (2 * mh + mm) * 16) * D_ + col0;
#pragma unroll
                    for (int bj = 0; bj < 2; ++bj) { r[mm][bj][0] = *(const f32x4*)(res + off + bj * HALF); r[mm][bj][1] = *(const f32x4*)(res + off + bj * HALF + 4); } }
#pragma unroll
                for (int mm = 0; mm < 2; ++mm) { const int m = 2 * mh + mm; const size_t off = (size_t)(row0 + ai * HALF + m * 16) * D_ + col0;
#pragma unroll
                    for (int bj = 0; bj < 2; ++bj) {
                        *(f32x4*)(out + off + bj * HALF) = r[mm][bj][0] + acc[ai][bj][m][0];
                        *(f32x4*)(out + off + bj * HALF + 4) = r[mm][bj][1] + acc[ai][bj][m][1]; } }
            }
    }
};
struct EpiRelu2 {
    bf16_t* H;
    DI void operator()(const AccT& acc, const Unit& u, int wr, int wc, int fr, int fq) const {
        const int row0 = u.pm * BM + wr * 64 + fr, col0 = u.pn * BM + wc * 32 + 8 * fq;
#pragma unroll
        for (int ai = 0; ai < 2; ++ai)
#pragma unroll
            for (int m = 0; m < 4; ++m) { bf16_t* rowp = H + (size_t)(row0 + ai * HALF + m * 16) * FF_ + col0;
#pragma unroll
                for (int bj = 0; bj < 2; ++bj) { f32x4 v0 = acc[ai][bj][m][0], v1 = acc[ai][bj][m][1];
#pragma unroll
                    for (int j = 0; j < 4; ++j) { const float a = fmaxf(v0[j], 0.f), b = fmaxf(v1[j], 0.f); v0[j] = a * a; v1[j] = b * b; }
                    u32x4 w; w.x = pk2(v0[0], v0[1]); w.y = pk2(v0[2], v0[3]); w.z = pk2(v1[0], v1[1]); w.w = pk2(v1[2], v1[3]);
                    *(u32x4*)(rowp + bj * HALF) = w; } }
    }
};
struct Seg { const char* A; const char* B; int K; int nt; };
struct MergeSrc { const bf16_t* A0; const bf16_t* A1; const bf16_t* A2; const bf16_t* B0; const bf16_t* B1; const bf16_t* B2; };
DI void merge_seg(const bf16_t* a0, const bf16_t* a1, const bf16_t* a2, const bf16_t* b0, const bf16_t* b1, const bf16_t* b2, int pm, int pn, int seg, Seg& o) {
    const int K = seg == 0 ? 1024 : 512;
    const bf16_t* a = seg == 0 ? a0 : (seg == 1 ? a1 : a2); const bf16_t* b = seg == 0 ? b0 : (seg == 1 ? b1 : b2);
    o.A = (const char*)a + (size_t)pm * 256 * K * 2; o.B = (const char*)b + (size_t)pn * 256 * K * 2; o.K = K; o.nt = K / BK;
}
template <class Epi, class Sched>
DI void merge_phase(LAS unsigned char* lds, const bf16_t* a0, const bf16_t* a1, const bf16_t* a2, const bf16_t* b0, const bf16_t* b1, const bf16_t* b2, const Sched& S, const Epi& E) {
    const int tid = fresh_tid(), wid = __builtin_amdgcn_readfirstlane(tid >> 6), lane = tid & 63, wr = wid >> 2, wc = wid & 3, fr = lane & 15, fq = lane >> 4;
    unsigned RA2[2], RB2[2], C2[2];
#pragma unroll
    for (int i = 0; i < 2; ++i) { int R, C; stage_rc(tid * 16 + i * 8192, R, C); const int Rb = (R & ~31) + perm32(R & 31);
        RA2[i] = (unsigned)R * 2u; RB2[i] = (unsigned)Rb * 2u; C2[i] = (unsigned)C * 2u; }
    const size_t kstep = (size_t)(BK * 2);
    const unsigned ldsw = (unsigned)wid * 1024u;
    const int aoff = lds_byte(wr * 64 + fr, fq * 8), boff = lds_byte(wc * 32 + fr, fq * 8);
#define PG8_SA(b, h) (((b) * 2 + (h)) * HTB)
#define PG8_SB(b, h) ((4 + (b) * 2 + (h)) * HTB)
#define PG8_STAGE(bufoff, gbase, RR, KK) do { _Pragma("unroll") for (int _i = 0; _i < 2; ++_i) \
        __builtin_amdgcn_global_load_lds((const unsigned*)((const char*)(gbase) + (RR[_i] * (unsigned)(KK) + C2[_i])), (LAS unsigned*)(lds + (bufoff) + ldsw + _i * 8192), 16, 0, 0); } while (0)
#define PG8_LDA(dst, b, h) do { _Pragma("unroll") for (int m = 0; m < 4; ++m) _Pragma("unroll") for (int k = 0; k < 2; ++k) dst[m][k] = *(const LAS bf16x8*)(lds + PG8_SA(b, h) + aoff + m * 2048 + k * 1024); } while (0)
#define PG8_LDB(dst, b, h) do { _Pragma("unroll") for (int n = 0; n < 2; ++n) _Pragma("unroll") for (int k = 0; k < 2; ++k) dst[n][k] = *(const LAS bf16x8*)(lds + PG8_SB(b, h) + boff + n * 2048 + k * 1024); } while (0)
#define PG8_MMA(ai, bj, At, Bt) do { __builtin_amdgcn_s_setprio(1); _Pragma("unroll") for (int m = 0; m < 4; ++m) _Pragma("unroll") for (int n = 0; n < 2; ++n) _Pragma("unroll") for (int k = 0; k < 2; ++k) \
        acc[ai][bj][m][n] = __builtin_amdgcn_mfma_f32_16x16x32_bf16(Bt[n][k], At[m][k], acc[ai][bj][m][n], 0, 0, 0); __builtin_amdgcn_s_setprio(0); } while (0)
#define PG8_WAIT_V(n) asm volatile("s_waitcnt vmcnt(" #n ")" ::: "memory")
#define PG8_WAIT_L(n) asm volatile("s_waitcnt lgkmcnt(" #n ")" ::: "memory")
#define PG8_BAR __builtin_amdgcn_s_barrier()
#define PG8_SCHED __builtin_amdgcn_sched_barrier(0)
    Unit cu, nu;
    if (!S.next(0, cu)) return;
    Seg cur, nxt; merge_seg(a0, a1, a2, b0, b1, b2, cu.pm, cu.pn, 0, cur);
    f32x4 acc[2][2][4][2];
#pragma unroll
    for (int a = 0; a < 2; ++a)
#pragma unroll
        for (int b = 0; b < 2; ++b)
#pragma unroll
            for (int m = 0; m < 4; ++m)
#pragma unroll
                for (int n = 0; n < 2; ++n) acc[a][b][m][n] = (f32x4){0.f, 0.f, 0.f, 0.f};
    bf16x8 At[4][2], B0[2][2], B1[2][2];
    {
        const char* cA = cur.A; const char* cB = cur.B; const int Kc = cur.K; const size_t hc = (size_t)HALF * Kc * 2;
        PG8_STAGE(PG8_SB(0, 0), cB, RB2, Kc); PG8_STAGE(PG8_SA(0, 0), cA, RA2, Kc); PG8_STAGE(PG8_SB(0, 1), cB + hc, RB2, Kc); PG8_STAGE(PG8_SA(0, 1), cA + hc, RA2, Kc);
        if (wr == 1) PG8_BAR;
        PG8_WAIT_V(4); PG8_BAR;
        PG8_STAGE(PG8_SB(1, 0), cB + kstep, RB2, Kc); PG8_STAGE(PG8_SA(1, 0), cA + kstep, RA2, Kc); PG8_STAGE(PG8_SB(1, 1), cB + hc + kstep, RB2, Kc);
        PG8_WAIT_V(6); PG8_BAR;
    }
#define MRG_KLOOP(CUR, NXT) do { \
        const char* cA = (CUR).A; const char* cB = (CUR).B; const int Kc = (CUR).K, Kn = (NXT).K, nt = (CUR).nt; const size_t hc = (size_t)HALF * Kc * 2; \
        for (int t = 0; t < nt; t += 2) { \
            asm volatile("" : "+v"(C2[0]), "+v"(C2[1])); \
            const bool last = (t == nt - 2); \
            const char* a1 = cA + (size_t)(t + 1) * kstep; \
            const char* a2 = last ? (NXT).A : cA + (size_t)(t + 2) * kstep; const char* b2 = last ? (NXT).B : cB + (size_t)(t + 2) * kstep; \
            const char* a3 = a2 + kstep; const char* b3 = b2 + kstep; \
            const int K2 = last ? Kn : Kc; const size_t h2 = (size_t)HALF * K2 * 2; \
            PG8_LDB(B0, 0, 0); PG8_SCHED; PG8_LDA(At, 0, 0); PG8_STAGE(PG8_SA(1, 1), a1 + hc, RA2, Kc); \
            PG8_WAIT_L(8); PG8_BAR; PG8_WAIT_L(0); PG8_MMA(0, 0, At, B0); PG8_BAR; PG8_SCHED; \
            PG8_LDB(B1, 0, 1); PG8_STAGE(PG8_SB(0, 0), b2, RB2, K2); \
            PG8_BAR; PG8_WAIT_L(0); PG8_MMA(0, 1, At, B1); PG8_BAR; \
            PG8_LDA(At, 0, 1); PG8_STAGE(PG8_SA(0, 0), a2, RA2, K2); \
            PG8_BAR; PG8_WAIT_L(0); PG8_MMA(1, 0, At, B0); PG8_BAR; PG8_SCHED; \
            PG8_STAGE(PG8_SB(0, 1), b2 + h2, RB2, K2); \
            PG8_WAIT_V(6); PG8_BAR; PG8_MMA(1, 1, At, B1); PG8_BAR; \
            PG8_LDB(B0, 1, 0); PG8_SCHED; PG8_LDA(At, 1, 0); PG8_STAGE(PG8_SA(0, 1), a2 + h2, RA2, K2); \
            PG8_WAIT_L(8); PG8_BAR; PG8_WAIT_L(0); PG8_MMA(0, 0, At, B0); PG8_BAR; PG8_SCHED; \
            PG8_LDB(B1, 1, 1); PG8_STAGE(PG8_SB(1, 0), b3, RB2, K2); \
            PG8_BAR; PG8_WAIT_L(0); PG8_MMA(0, 1, At, B1); PG8_BAR; \
            PG8_LDA(At, 1, 1); PG8_STAGE(PG8_SA(1, 0), a3, RA2, K2); \
            PG8_BAR; PG8_WAIT_L(0); PG8_MMA(1, 0, At, B0); PG8_BAR; PG8_SCHED; \
            PG8_STAGE(PG8_SB(1, 1), b3 + h2, RB2, K2); \
            PG8_WAIT_V(6); PG8_BAR; PG8_MMA(1, 1, At, B1); PG8_BAR; \
        } } while (0)
    for (int ui = 0;; ++ui) {
        Seg s1, s2; merge_seg(a0, a1, a2, b0, b1, b2, cu.pm, cu.pn, 1, s1); merge_seg(a0, a1, a2, b0, b1, b2, cu.pm, cu.pn, 2, s2);
        const bool has_next = S.next(ui + 1, nu);
        if (has_next) merge_seg(a0, a1, a2, b0, b1, b2, nu.pm, nu.pn, 0, nxt); else nxt = s2;
        MRG_KLOOP(cur, s1);
        E.mid(acc, cu, 0, wr, wc, fr, fq);
        MRG_KLOOP(s1, s2);
        E.mid(acc, cu, 1, wr, wc, fr, fq);
        MRG_KLOOP(s2, nxt);
        E.fin(acc, cu, wr, wc, fr, fq);
#pragma unroll
        for (int a = 0; a < 2; ++a)
#pragma unroll
            for (int b = 0; b < 2; ++b)
#pragma unroll
                for (int m = 0; m < 4; ++m)
#pragma unroll
                    for (int n = 0; n < 2; ++n) acc[a][b][m][n] = (f32x4){0.f, 0.f, 0.f, 0.f};
        if (!has_next) break;
        cur = nxt; cu = nu;
    }
#undef MRG_KLOOP
    PG8_WAIT_V(0);
    if (wr == 0) PG8_BAR;
    PG8_BAR;
#undef PG8_SA
#undef PG8_SB
#undef PG8_STAGE
#undef PG8_LDA
#undef PG8_LDB
#undef PG8_MMA
#undef PG8_WAIT_V
#undef PG8_WAIT_L
#undef PG8_BAR
#undef PG8_SCHED
}


struct EpiMerge {
    bf16_t* Mg; const bf16_t* G; const float* bias;
    DI void mid(AccT& acc, const Unit& u, int seg, int wr, int wc, int fr, int fq) const {
        const int row0 = u.pm * BM + wr * 64 + fr, col0 = u.pn * BM + wc * 32 + 8 * fq;
        const unsigned char* pa = (const unsigned char*)G + (size_t)row0 * NGATE + seg * 2048 + col0;
#pragma unroll
        for (int ai = 0; ai < 2; ++ai) {
#pragma unroll
            for (int mh = 0; mh < 2; ++mh) {
                u32x2 ra[2][2], rb[2][2];
#pragma unroll
                for (int mm = 0; mm < 2; ++mm)
#pragma unroll
                    for (int bj = 0; bj < 2; ++bj) { const unsigned char* p = pa + (size_t)(mm * 16) * NGATE + bj * HALF; ra[mm][bj] = *(const u32x2*)p; rb[mm][bj] = *(const u32x2*)(p + 2048); }
#pragma unroll
                for (int mm = 0; mm < 2; ++mm)
#pragma unroll
                    for (int bj = 0; bj < 2; ++bj) {
                        float ga[8], gb[8];
                        unpack_gate8(ra[mm][bj], ga); unpack_gate8(rb[mm][bj], gb);
                        const int m = 2 * mh + mm;
#pragma unroll
                        for (int j = 0; j < 4; ++j) { const float r0 = ga[j] * __builtin_amdgcn_rcpf(gb[j]), r1 = ga[4 + j] * __builtin_amdgcn_rcpf(gb[4 + j]);
                            acc[ai][bj][m][0][j] *= r0; acc[ai][bj][m][1][j] *= r1; } }
                pa += (size_t)(mh == 1 ? 96 : 32) * NGATE;
                asm volatile("" : "+v"(pa));
            } }
    }
    DI void fin(const AccT& acc, const Unit& u, int wr, int wc, int fr, int fq) const {
        const int row0 = u.pm * BM + wr * 64 + fr, col0 = u.pn * BM + wc * 32 + 8 * fq;
        const unsigned char* pg = (const unsigned char*)G + (size_t)row0 * NGATE + 4096 + col0;
        bf16_t* pm_ = Mg + (size_t)row0 * D_ + col0;
        f32x4 bv[2][2];
#pragma unroll
        for (int bj = 0; bj < 2; ++bj)
#pragma unroll
            for (int n = 0; n < 2; ++n) bv[bj][n] = *(const f32x4*)(bias + col0 + bj * HALF + 4 * n);
#pragma unroll
        for (int ai = 0; ai < 2; ++ai) {
#pragma unroll
            for (int mh = 0; mh < 2; ++mh) {
                u32x2 rg[2][2];
#pragma unroll
                for (int mm = 0; mm < 2; ++mm)
#pragma unroll
                    for (int bj = 0; bj < 2; ++bj) rg[mm][bj] = *(const u32x2*)(pg + (size_t)(mm * 16) * NGATE + bj * HALF);
#pragma unroll
                for (int mm = 0; mm < 2; ++mm)
#pragma unroll
                    for (int bj = 0; bj < 2; ++bj) {
                        const int m = 2 * mh + mm;
                        float gv[8], o[8];
                        unpack_gate8(rg[mm][bj], gv);
                        const f32x4 v0 = acc[ai][bj][m][0] + bv[bj][0], v1 = acc[ai][bj][m][1] + bv[bj][1];
#pragma unroll
                        for (int j = 0; j < 4; ++j) { o[j] = gv[j] * (1.f / 255.f) * v0[j]; o[4 + j] = gv[4 + j] * (1.f / 255.f) * v1[j]; }
                        *(u32x4*)(pm_ + (size_t)(mm * 16) * D_ + bj * HALF) = pack8(o); }
                pg += (size_t)(mh == 1 ? 96 : 32) * NGATE; pm_ += (size_t)(mh == 1 ? 96 : 32) * D_;
                asm volatile("" : "+v"(pg), "+v"(pm_));
            } }
    }
};
}

template <bool INMAP>
DI void transpose_item(const float* W, int K, int N, int nblk, bf16_t* WT, int row_off, LAS float* scr, int item, int lane) {
    const int kb = item / nblk, nb = item % nblk, k0 = 64 * kb, n0 = 64 * nb;
    const int q = lane & 15, kr = lane >> 4;
    const int np = n0 + 4 * q;
    int ns = np;
    if (INMAP) ns = np < 2640 ? np : (np < 2816 ? -1 : np - 176);
#pragma unroll 16
    for (int i = 0; i < 16; ++i) { const int kk = 4 * i + kr;
        f32x4 v = {0.f, 0.f, 0.f, 0.f};
        if (ns >= 0) v = __builtin_nontemporal_load((const f32x4*)(W + (size_t)(k0 + kk) * N + ns));
        LAS float* d = scr + kk * 65 + 4 * q; d[0] = v.x; d[1] = v.y; d[2] = v.z; d[3] = v.w; }
    asm volatile("s_waitcnt lgkmcnt(0)" ::: "memory");
    const int c = lane & 7;
#pragma unroll
    for (int j = 0; j < 8; ++j) { const int n = (lane >> 3) + 8 * j; const LAS float* s = scr + (8 * c) * 65 + n;
        u32x4 o; o.x = pk2(s[0 * 65], s[1 * 65]); o.y = pk2(s[2 * 65], s[3 * 65]); o.z = pk2(s[4 * 65], s[5 * 65]); o.w = pk2(s[6 * 65], s[7 * 65]);
        *(u32x4*)(WT + (size_t)(row_off + n0 + n) * K + k0 + 8 * c) = o; }
    asm volatile("s_waitcnt lgkmcnt(0)" ::: "memory");
}
DI void rms_row_to_bf16(const float* xrow, const float* g, bf16_t* orow, int lane) {
    const f32x4* xr = (const f32x4*)xrow + lane; const f32x4* gr = (const f32x4*)g + lane;
    f32x4 v[8]; float s = 0.f;
#pragma unroll
    for (int j = 0; j < 8; ++j) { v[j] = xr[64 * j]; s += (v[j].x * v[j].x + v[j].y * v[j].y) + (v[j].z * v[j].z + v[j].w * v[j].w); }
    const float rs = rsqrtf(wave_sum(s) * (1.f / D_) + EPS_);
    u32x2* o8 = (u32x2*)orow + lane;
#pragma unroll
    for (int j = 0; j < 8; ++j) { const f32x4 gg = gr[64 * j]; u32x2 w; w.x = pk2(v[j].x * rs * gg.x, v[j].y * rs * gg.y); w.y = pk2(v[j].z * rs * gg.z, v[j].w * rs * gg.w); o8[64 * j] = w; }
}

DI void rms_rows2_to_bf16(const float* x0, const float* g0, bf16_t* o0, const float* x1, const float* g1, bf16_t* o1, int lane) {
    const f32x4* xr0 = (const f32x4*)x0 + lane; const f32x4* xr1 = (const f32x4*)x1 + lane;
    f32x4 v0[8], v1[8]; float s0 = 0.f, s1 = 0.f;
#pragma unroll
    for (int j = 0; j < 8; ++j) { v0[j] = xr0[64 * j]; v1[j] = xr1[64 * j]; }
#pragma unroll
    for (int j = 0; j < 8; ++j) { s0 += (v0[j].x * v0[j].x + v0[j].y * v0[j].y) + (v0[j].z * v0[j].z + v0[j].w * v0[j].w); s1 += (v1[j].x * v1[j].x + v1[j].y * v1[j].y) + (v1[j].z * v1[j].z + v1[j].w * v1[j].w); }
    const float r0 = rsqrtf(wave_sum(s0) * (1.f / D_) + EPS_), r1 = rsqrtf(wave_sum(s1) * (1.f / D_) + EPS_);
    const f32x4* gr0 = (const f32x4*)g0 + lane; const f32x4* gr1 = (const f32x4*)g1 + lane;
    u32x2* p0 = (u32x2*)o0 + lane; u32x2* p1 = (u32x2*)o1 + lane;
#pragma unroll
    for (int j = 0; j < 8; ++j) { const f32x4 ga = gr0[64 * j], gb = gr1[64 * j]; u32x2 w;
        w.x = pk2(v0[j].x * r0 * ga.x, v0[j].y * r0 * ga.y); w.y = pk2(v0[j].z * r0 * ga.z, v0[j].w * r0 * ga.w); p0[64 * j] = w;
        w.x = pk2(v1[j].x * r1 * gb.x, v1[j].y * r1 * gb.y); w.y = pk2(v1[j].z * r1 * gb.z, v1[j].w * r1 * gb.w); p1[64 * j] = w; }
}
DI void rms_rows4_to_bf16(const float* xb, size_t xstride, const float* g, bf16_t* ob, size_t ostride, int lane) {
    f32x4 v[4][8]; float ss[4];
#pragma unroll
    for (int r = 0; r < 4; ++r)
#pragma unroll
        for (int j = 0; j < 8; ++j) v[r][j] = ((const f32x4*)(xb + r * xstride))[lane + 64 * j];
#pragma unroll
    for (int r = 0; r < 4; ++r) { float s = 0.f;
#pragma unroll
        for (int j = 0; j < 8; ++j) s += (v[r][j].x * v[r][j].x + v[r][j].y * v[r][j].y) + (v[r][j].z * v[r][j].z + v[r][j].w * v[r][j].w);
        ss[r] = rsqrtf(wave_sum(s) * (1.f / D_) + EPS_); }
    const f32x4* gr = (const f32x4*)g + lane;
#pragma unroll
    for (int j = 0; j < 8; ++j) { const f32x4 gg = gr[64 * j];
#pragma unroll
        for (int r = 0; r < 4; ++r) { u32x2 w; w.x = pk2(v[r][j].x * ss[r] * gg.x, v[r][j].y * ss[r] * gg.y); w.y = pk2(v[r][j].z * ss[r] * gg.z, v[r][j].w * ss[r] * gg.w);
            ((u32x2*)(ob + r * ostride))[lane + 64 * j] = w; } }
}
DI void load16(const bf16_t* p, float* v) { unpack8(*(const u32x4*)p, v); unpack8(*(const u32x4*)(p + 8), v + 8); }
DI void store16(bf16_t* p, const float* v) { *(u32x4*)p = pack8(v); *(u32x4*)(p + 8) = pack8(v + 8); }

DI void post_token(int tok, int lane, LAS float* cs  , const bf16_t* P, const int* positions,
                   const float* gq, const float* gk, const float* gmq, const float* cinb,
                   bf16_t* Q, bf16_t* Kb, bf16_t* IQ, bf16_t* IK, float* IW, bf16_t* U, bf16_t* MQ) {
    const bf16_t* prow = P + (size_t)tok * NPROJ;
    const u32x4 rq0 = *(const u32x4*)(prow + PC_Q + 16 * lane), rq1 = *(const u32x4*)(prow + PC_Q + 16 * lane + 8);
    const u32x4 rk0 = *(const u32x4*)(prow + PC_K + 16 * (lane & 15)), rk1 = *(const u32x4*)(prow + PC_K + 16 * (lane & 15) + 8);
    const u32x4 ri0 = *(const u32x4*)(prow + PC_IQ + 16 * lane), ri1 = *(const u32x4*)(prow + PC_IQ + 16 * lane + 8);
    const u32x4 rj0 = *(const u32x4*)(prow + PC_IK + 16 * (lane & 3)), rj1 = *(const u32x4*)(prow + PC_IK + 16 * (lane & 3) + 8);
    const unsigned short rw = prow[PC_IW + (lane & 15)];
    const u32x4 rga = *(const u32x4*)(prow + PC_GLU + 8 * lane), rgg = *(const u32x4*)(prow + PC_GLU + 512 + 8 * lane);
    const u32x4 rm0 = *(const u32x4*)(prow + PC_MQ + 16 * (lane & 31)), rm1 = *(const u32x4*)(prow + PC_MQ + 16 * (lane & 31) + 8);
    const int posv = positions[tok];
    if (lane < 16) {
        const float inv = exp2f(-(float)lane * (1.0f / 16.0f) * 18.931568569324174f);
        const float ang = (float)posv * inv;
        const double xd = (double)ang; const double kq = rint(xd * 0.15915494309189535); const float rf = (float)fma(-kq, 6.283185307179586, xd);
        cs[lane] = __cosf(rf); cs[16 + lane] = __sinf(rf);
    }
    asm volatile("s_waitcnt lgkmcnt(0)" ::: "memory");
    __builtin_amdgcn_wave_barrier();
    float v[16];
    {
        unpack8(rq0, v); unpack8(rq1, v + 8);
        float ss = 0.f;
#pragma unroll
        for (int i = 0; i < 16; ++i) ss += v[i] * v[i];
        ss += __shfl_xor(ss, 1); ss += __shfl_xor(ss, 2); ss += __shfl_xor(ss, 4);
        const float rs = rsqrtf(ss * (1.f / 128.f) + EPS_);
        const int d0 = 16 * (lane & 7);
#pragma unroll
        for (int i = 0; i < 16; ++i) v[i] = v[i] * rs * gq[d0 + i];
        const int sub = lane & 7;
#pragma unroll
        for (int i = 0; i < 16; ++i) { const float oth = __shfl_xor(v[i], 1); const float c = cs[i], s = cs[16 + i];
            if (sub == 0) v[i] = v[i] * c - oth * s; else if (sub == 1) v[i] = v[i] * c + oth * s; }
        store16(Q + (size_t)tok * 1024 + 16 * lane, v);
    }
    {
        const int ln = lane & 15;
        unpack8(rk0, v); unpack8(rk1, v + 8);
        float ss = 0.f;
#pragma unroll
        for (int i = 0; i < 16; ++i) ss += v[i] * v[i];
        ss += __shfl_xor(ss, 1); ss += __shfl_xor(ss, 2); ss += __shfl_xor(ss, 4);
        const float rs = rsqrtf(ss * (1.f / 128.f) + EPS_);
        const int d0 = 16 * (ln & 7);
#pragma unroll
        for (int i = 0; i < 16; ++i) v[i] = v[i] * rs * gk[d0 + i];
        const int sub = ln & 7;
#pragma unroll
        for (int i = 0; i < 16; ++i) { const float oth = __shfl_xor(v[i], 1); const float c = cs[i], s = cs[16 + i];
            if (sub == 0) v[i] = v[i] * c - oth * s; else if (sub == 1) v[i] = v[i] * c + oth * s; }
        if (lane < 16) store16(Kb + (size_t)tok * 256 + 16 * ln, v);
    }
    {
        unpack8(ri0, v); unpack8(ri1, v + 8);
        if ((lane & 3) == 0) {
#pragma unroll
            for (int i = 0; i < 8; ++i) { const float c = cs[2 * i], s = cs[16 + 2 * i]; const float a = v[i], b = v[i + 8]; v[i] = a * c - b * s; v[i + 8] = b * c + a * s; }
        }
        store16(IQ + (size_t)tok * 1024 + 16 * lane, v);
    }
    {
        const int ln = lane & 3;
        unpack8(rj0, v); unpack8(rj1, v + 8);
        if (ln == 0) {
#pragma unroll
            for (int i = 0; i < 8; ++i) { const float c = cs[2 * i], s = cs[16 + 2 * i]; const float a = v[i], b = v[i + 8]; v[i] = a * c - b * s; v[i + 8] = b * c + a * s; }
        }
        if (lane < 4) store16(IK + (size_t)tok * 64 + 16 * ln, v);
    }
    if (lane < 16) IW[(size_t)tok * 16 + lane] = bf2f(rw) * 0.03125f;
    {
        float a[8], gt[8], o[8];
        unpack8(rga, a);
        unpack8(rgg, gt);
#pragma unroll
        for (int i = 0; i < 8; ++i) o[i] = (a[i] + cinb[8 * lane + i]) * sigmoidf_(gt[i] + cinb[512 + 8 * lane + i]);
        *(u32x4*)(U + (size_t)tok * 512 + 8 * lane) = pack8(o);
    }
    {
        const int ln = lane & 31;
        unpack8(rm0, v); unpack8(rm1, v + 8);
        float ss = 0.f;
#pragma unroll
        for (int i = 0; i < 16; ++i) ss += v[i] * v[i];
        ss += __shfl_xor(ss, 1); ss += __shfl_xor(ss, 2); ss += __shfl_xor(ss, 4);
        const float rs = rsqrtf(ss * (1.f / 128.f) + EPS_);
        const int d0 = 16 * (ln & 7);
#pragma unroll
        for (int i = 0; i < 16; ++i) v[i] = v[i] * rs * gmq[d0 + i];
        if (lane < 32) store16(MQ + (size_t)tok * 512 + 16 * ln, v);
    }
    __builtin_amdgcn_wave_barrier();
}
DI void transpose64x128(const bf16_t* src, int pitch, bf16_t* dst, int dpitch, int lane) {
    const bf16_t* sp = src + (size_t)lane * pitch;
    u32x4 wq[16];
#pragma unroll
    for (int c = 0; c < 16; ++c) wq[c] = *(const u32x4*)(sp + 8 * c);
#pragma unroll
    for (int c = 0; c < 16; ++c) {
        const u32x4 w = wq[c];
        bf16_t* dp = dst + (size_t)(8 * c) * dpitch + lane;
        dp[0] = (bf16_t)(w.x & 0xffffu); dp[dpitch] = (bf16_t)(w.x >> 16);
        dp[2 * (size_t)dpitch] = (bf16_t)(w.y & 0xffffu); dp[3 * (size_t)dpitch] = (bf16_t)(w.y >> 16);
        dp[4 * (size_t)dpitch] = (bf16_t)(w.z & 0xffffu); dp[5 * (size_t)dpitch] = (bf16_t)(w.z >> 16);
        dp[6 * (size_t)dpitch] = (bf16_t)(w.w & 0xffffu); dp[7 * (size_t)dpitch] = (bf16_t)(w.w >> 16);
    }
}
DI void post_memrow(int row, int lane, const bf16_t* MKV, const float* gmk, bf16_t* MK) {
    float v[16];
    const int ln = lane & 31;
    load16(MKV + (size_t)row * 1024 + 16 * ln, v);
    float ss = 0.f;
#pragma unroll
    for (int i = 0; i < 16; ++i) ss += v[i] * v[i];
    ss += __shfl_xor(ss, 1); ss += __shfl_xor(ss, 2); ss += __shfl_xor(ss, 4);
    const float rs = rsqrtf(ss * (1.f / 128.f) + EPS_);
    const int d0 = 16 * (ln & 7);
#pragma unroll
    for (int i = 0; i < 16; ++i) v[i] = v[i] * rs * gmk[d0 + i];
    if (lane < 32) store16(MK + (size_t)row * 512 + 16 * ln, v);
}

constexpr int IDX_PITCH = 144, IDX_BUF = 256 * IDX_PITCH;
DI unsigned sortable(float f) { const unsigned b = __float_as_uint(f); return b ^ ((unsigned)((int)b >> 31) | 0x80000000u); }
DI int count_ge8(unsigned cand, unsigned a0, unsigned a1, unsigned a2, unsigned a3, unsigned a4, unsigned a5, unsigned a6, unsigned a7) {
    unsigned long long m0, m1, m2, m3, m4, m5, m6, m7;
    asm("v_cmp_le_u32_e64 %0, %8, %9\n\tv_cmp_le_u32_e64 %1, %8, %10\n\tv_cmp_le_u32_e64 %2, %8, %11\n\tv_cmp_le_u32_e64 %3, %8, %12\n\t"
        "v_cmp_le_u32_e64 %4, %8, %13\n\tv_cmp_le_u32_e64 %5, %8, %14\n\tv_cmp_le_u32_e64 %6, %8, %15\n\tv_cmp_le_u32_e64 %7, %8, %16"
        : "=&s"(m0), "=&s"(m1), "=&s"(m2), "=&s"(m3), "=&s"(m4), "=&s"(m5), "=&s"(m6), "=&s"(m7)
        : "s"(cand), "v"(a0), "v"(a1), "v"(a2), "v"(a3), "v"(a4), "v"(a5), "v"(a6), "v"(a7));
    return (__builtin_popcountll(m0) + __builtin_popcountll(m1)) + (__builtin_popcountll(m2) + __builtin_popcountll(m3)) +
           (__builtin_popcountll(m4) + __builtin_popcountll(m5)) + (__builtin_popcountll(m6) + __builtin_popcountll(m7));
}
DI float relu1(float x) { const int b = (int)__float_as_uint(x); return __uint_as_float((unsigned)(b > 0 ? b : 0)); }
typedef unsigned u32x2s __attribute__((ext_vector_type(2)));
DI float swap16_add(float a, float b) { const u32x2s r = __builtin_amdgcn_permlane16_swap(__float_as_uint(a), __float_as_uint(b), false, false); return __uint_as_float(r.x) + __uint_as_float(r.y); }
DI float swap32_add(float a, float b) { const u32x2s r = __builtin_amdgcn_permlane32_swap(__float_as_uint(a), __float_as_uint(b), false, false); return __uint_as_float(r.x) + __uint_as_float(r.y); }
DI void idx_rows(LAS unsigned char* lds, int b, int tg, const bf16_t* IQ, const bf16_t* IK, const float* IW, unsigned long long* maskT) {
    const int tid = fresh_tid(), lane = tid & 63, wave = __builtin_amdgcn_readfirstlane(tid >> 6);
    const int g = lane >> 4, c16 = lane & 15;
    const int tb = tg * 8; const size_t rowb = (size_t)b * S_ + tb;
    const int ngrp = (tb + 7) / 64 + 1;
    LAS unsigned* stab = (LAS unsigned*)lds;
    {
        bf16x8 a0[8], a1[8]; f32x4 wv[8];
#pragma unroll
        for (int j = 0; j < 8; ++j) {
            a0[j] = *(const bf16x8*)(IQ + (rowb + j) * 1024 + c16 * 64 + g * 8);
            a1[j] = *(const bf16x8*)(IQ + (rowb + j) * 1024 + c16 * 64 + 32 + g * 8);
            wv[j] = *(const f32x4*)(IW + (rowb + j) * 16 + 4 * g);
        }
        const bf16_t* ikl = IK + (size_t)b * S_ * 64 + c16 * 64 + g * 8;
        bf16x8 bA[4][2], bB[4][2];
#define IDX_LOADG(dst, grp_) do { _Pragma("unroll") for (int tt = 0; tt < 4; ++tt) { const bf16_t* p_ = ikl + (size_t)(64 * (grp_) + 16 * tt) * 64; dst[tt][0] = *(const bf16x8*)p_; dst[tt][1] = *(const bf16x8*)(p_ + 32); } } while (0)
#define IDX_COMPUTE(src, grp_) do { _Pragma("unroll") for (int j = 0; j < 8; ++j) { \
            f32x4 acc[4]; \
            _Pragma("unroll") for (int tt = 0; tt < 4; ++tt) acc[tt] = __builtin_amdgcn_mfma_f32_16x16x32_bf16(a0[j], src[tt][0], (f32x4){0.f, 0.f, 0.f, 0.f}, 0, 0, 0); \
            _Pragma("unroll") for (int tt = 0; tt < 4; ++tt) acc[tt] = __builtin_amdgcn_mfma_f32_16x16x32_bf16(a1[j], src[tt][1], acc[tt], 0, 0, 0); \
            float v[4]; \
            _Pragma("unroll") for (int tt = 0; tt < 4; ++tt) { const f32x2 r01 = {relu1(acc[tt][0]), relu1(acc[tt][1])}, r23 = {relu1(acc[tt][2]), relu1(acc[tt][3])}; \
                const f32x2 w01 = {wv[j][0], wv[j][1]}, w23 = {wv[j][2], wv[j][3]}; const f32x2 p = w01 * r01 + w23 * r23; v[tt] = p.x + p.y; } \
            const float x01 = swap16_add(v[0], v[1]); const float x23 = swap16_add(v[2], v[3]); const float z = swap32_add(x01, x23); \
            const int key = 64 * (grp_) + lane; \
            stab[j * 4096 + key] = key <= tb + j ? sortable(z) : 0u; } } while (0)
        __syncthreads();
        if (wave < ngrp) IDX_LOADG(bA, wave);
        for (int grp = wave; grp < ngrp; grp += 16) {
            if (grp + 8 < ngrp) IDX_LOADG(bB, grp + 8);
            IDX_COMPUTE(bA, grp);
            if (grp + 8 < ngrp) {
                if (grp + 16 < ngrp) IDX_LOADG(bA, grp + 16);
                IDX_COMPUTE(bB, grp + 8);
            }
        }
#undef IDX_LOADG
#undef IDX_COMPUTE
    }
    __syncthreads();
    const int t = tb + wave;
    unsigned sc[64];
#pragma unroll
    for (int i8 = 0; i8 < 8; ++i8) {
        if (8 * i8 <= (t >> 6)) {
#pragma unroll
            for (int ii = 0; ii < 8; ++ii) sc[8 * i8 + ii] = (8 * i8 + ii) < ngrp ? stab[wave * 4096 + 64 * (8 * i8 + ii) + lane] : 0u;
        } else {
#pragma unroll
            for (int ii = 0; ii < 8; ++ii) sc[8 * i8 + ii] = 0u;
        }
    }
    const int imax = t >> 6;
    const bool all = (t + 1) <= 256;
    unsigned th = 0u;
    bool exact = false;
    if (!all) {
        for (int bit = 31; bit >= 0; --bit) {
            const unsigned cand = th | (1u << bit);
            int cnt = 0;
#pragma unroll
            for (int i8 = 0; i8 < 8; ++i8) {
                if (8 * i8 <= imax) cnt += count_ge8(cand, sc[8 * i8], sc[8 * i8 + 1], sc[8 * i8 + 2], sc[8 * i8 + 3], sc[8 * i8 + 4], sc[8 * i8 + 5], sc[8 * i8 + 6], sc[8 * i8 + 7]);
            }
            if (cnt >= 256) { th = cand; if (cnt == 256) { exact = true; break; } }
        }
    }
    int need = 0;
    if (!all) {
        if (exact) need = 8192;
        else {
            int cgt = 0;
#pragma unroll
            for (int i8 = 0; i8 < 8; ++i8) {
                if (8 * i8 <= imax) {
#pragma unroll
                    for (int i = 0; i < 8; ++i) cgt += __builtin_popcountll(__ballot(sc[8 * i8 + i] > th));
                }
            }
            need = 256 - cgt;
        }
    }
    unsigned mlo = 0u, mhi = 0u;
    if (all || exact) {
        const unsigned thr = all ? 1u : th;
#pragma unroll
        for (int i8 = 0; i8 < 8; ++i8) {
            if (8 * i8 <= imax) {
#pragma unroll
                for (int ii = 0; ii < 8; ++ii) {
                    const int i = 8 * i8 + ii;
                    const unsigned long long word = __ballot(sc[i] >= thr);
                    if (lane == i) { mlo = (unsigned)word; mhi = (unsigned)(word >> 32); }
                }
            }
        }
    } else {
#pragma unroll
        for (int i8 = 0; i8 < 8; ++i8) {
            if (8 * i8 <= imax) {
#pragma unroll
                for (int ii = 0; ii < 8; ++ii) {
                    const int i = 8 * i8 + ii;
                    const unsigned long long gt = __ballot(sc[i] > th);
                    unsigned long long eq = __ballot(sc[i] == th);
                    if (need > 0 && eq != 0ull) {
                        int cq = __builtin_popcountll(eq);
                        while (cq > need) { eq &= ~(1ull << (63 - __builtin_clzll(eq))); --cq; }
                        need -= cq;
                    } else eq = 0ull;
                    const unsigned long long word = gt | eq;
                    if (lane == i) { mlo = (unsigned)word; mhi = (unsigned)(word >> 32); }
                }
            }
        }
    }
    const unsigned long long myword = ((unsigned long long)mhi << 32) | mlo;
    if (lane <= imax) maskT[((size_t)b * 64 + lane) * S_ + t] = myword;
}

constexpr int AK_PITCH = 272, AV_PITCH = 136, AK_BYTES = 64 * AK_PITCH, AV_BYTES = 128 * AV_PITCH, ABUF = AK_BYTES + AV_BYTES;
template <bool MASK>
DI void attn_unit(LAS unsigned char* lds, const bf16_t* qrow, const bf16_t* kbase, int kpitch, const bf16_t* vtbase, int vtpitch, int ntiles,
                  const unsigned long long* maskp, bf16_t* orow, float c1, float c2) {
    const int tid = fresh_tid(), lane = tid & 63, r = lane & 31, h = lane >> 5;
    bf16x8 qf[8];
#pragma unroll
    for (int ks = 0; ks < 8; ++ks) qf[ks] = *(const bf16x8*)(qrow + 16 * ks + 8 * h);
    f32x16 o[4];
#pragma unroll
    for (int d = 0; d < 4; ++d)
#pragma unroll
        for (int i = 0; i < 16; ++i) o[d][i] = 0.f;
    float l = 0.f;
    u32x4 pk[2], pv[2];
    const int ke0 = tid, ke1 = tid + 512;
    const bf16_t* kg0 = kbase + (size_t)(ke0 >> 4) * kpitch + (ke0 & 15) * 8; const bf16_t* kg1 = kbase + (size_t)(ke1 >> 4) * kpitch + (ke1 & 15) * 8;
    const int kl0 = (ke0 >> 4) * AK_PITCH + (ke0 & 15) * 16, kl1 = (ke1 >> 4) * AK_PITCH + (ke1 & 15) * 16;
    const bf16_t* vg0 = vtbase + (size_t)(ke0 >> 3) * vtpitch + (ke0 & 7) * 8; const bf16_t* vg1 = vtbase + (size_t)(ke1 >> 3) * vtpitch + (ke1 & 7) * 8;
    const int vl0 = AK_BYTES + (ke0 >> 3) * AV_PITCH + (ke0 & 7) * 16, vl1 = AK_BYTES + (ke1 >> 3) * AV_PITCH + (ke1 & 7) * 16;
    pk[0] = *(const u32x4*)kg0; pk[1] = *(const u32x4*)kg1; pv[0] = *(const u32x4*)vg0; pv[1] = *(const u32x4*)vg1;
    {
        LAS unsigned char* nb = lds;
        *(LAS u32x4*)(nb + kl0) = pk[0]; *(LAS u32x4*)(nb + kl1) = pk[1];
        *(LAS u32x2*)(nb + vl0) = (u32x2){pv[0].x, pv[0].y}; *(LAS u32x2*)(nb + vl0 + 8) = (u32x2){pv[0].z, pv[0].w};
        *(LAS u32x2*)(nb + vl1) = (u32x2){pv[1].x, pv[1].y}; *(LAS u32x2*)(nb + vl1 + 8) = (u32x2){pv[1].z, pv[1].w};
    }
    unsigned long long mw_next = ~0ull;
    if (MASK) mw_next = maskp[0];
    __syncthreads();
    for (int kt = 0; kt < ntiles; ++kt) {
        const bool more = kt + 1 < ntiles;
        if (more) {
            const size_t ko = (size_t)(kt + 1) * 64 * kpitch; const int vo = (kt + 1) * 64;
            pk[0] = *(const u32x4*)(kg0 + ko); pk[1] = *(const u32x4*)(kg1 + ko); pv[0] = *(const u32x4*)(vg0 + vo); pv[1] = *(const u32x4*)(vg1 + vo);
        }
        const unsigned long long mw = mw_next;
        if (MASK && more) mw_next = maskp[(size_t)(kt + 1) * S_];
        LAS unsigned char* buf = lds + (kt & 1) * ABUF;
        f32x16 xs[2];
#pragma unroll
        for (int sub = 0; sub < 2; ++sub) {
#pragma unroll
            for (int i = 0; i < 16; ++i) xs[sub][i] = 0.f;
            __builtin_amdgcn_s_setprio(1);
#pragma unroll
            for (int ks = 0; ks < 8; ++ks) {
                const bf16x8 a = *(const LAS bf16x8*)(buf + (32 * sub + r) * AK_PITCH + ks * 32 + h * 16);
                xs[sub] = __builtin_amdgcn_mfma_f32_32x32x16_bf16(a, qf[ks], xs[sub], 0, 0, 0);
            }
            __builtin_amdgcn_s_setprio(0);
        }
#pragma unroll
        for (int sub = 0; sub < 2; ++sub) {
            const unsigned mws = ((unsigned)(mw >> (32 * sub))) >> (4 * h);
            float pe[16];
#pragma unroll
            for (int i = 0; i < 16; ++i) {
                float p = __builtin_amdgcn_exp2f(xs[sub][i] * c1 - c2);
                if (MASK) { const int m = __builtin_amdgcn_sbfe((int)mws, (i & 3) + 8 * (i >> 2), 1); p = __uint_as_float(__float_as_uint(p) & (unsigned)m); }
                l += p; pe[i] = p;
            }
            u32x4 p0, p1;
            p0.x = pk2(pe[0], pe[1]); p0.y = pk2(pe[2], pe[3]); p0.z = pk2(pe[4], pe[5]); p0.w = pk2(pe[6], pe[7]);
            p1.x = pk2(pe[8], pe[9]); p1.y = pk2(pe[10], pe[11]); p1.z = pk2(pe[12], pe[13]); p1.w = pk2(pe[14], pe[15]);
            const bf16x8 pb0 = __builtin_bit_cast(bf16x8, p0), pb1 = __builtin_bit_cast(bf16x8, p1);
#pragma unroll
            for (int dt = 0; dt < 4; ++dt) {
                const LAS unsigned char* vp = buf + AK_BYTES + (32 * dt + r) * AV_PITCH + (32 * sub + 4 * h) * 2;
                const s16x4 lo0 = *(const LAS s16x4*)(vp), hi0 = *(const LAS s16x4*)(vp + 16);
                const s16x4 lo1 = *(const LAS s16x4*)(vp + 32), hi1 = *(const LAS s16x4*)(vp + 48);
                const bf16x8 va0 = __builtin_shufflevector(lo0, hi0, 0, 1, 2, 3, 4, 5, 6, 7);
                const bf16x8 va1 = __builtin_shufflevector(lo1, hi1, 0, 1, 2, 3, 4, 5, 6, 7);
                o[dt] = __builtin_amdgcn_mfma_f32_32x32x16_bf16(va0, pb0, o[dt], 0, 0, 0);
                o[dt] = __builtin_amdgcn_mfma_f32_32x32x16_bf16(va1, pb1, o[dt], 0, 0, 0);
            }
        }
        if (more) {
            LAS unsigned char* nb = lds + ((kt + 1) & 1) * ABUF;
            *(LAS u32x4*)(nb + kl0) = pk[0]; *(LAS u32x4*)(nb + kl1) = pk[1];
            *(LAS u32x2*)(nb + vl0) = (u32x2){pv[0].x, pv[0].y}; *(LAS u32x2*)(nb + vl0 + 8) = (u32x2){pv[0].z, pv[0].w};
            *(LAS u32x2*)(nb + vl1) = (u32x2){pv[1].x, pv[1].y}; *(LAS u32x2*)(nb + vl1 + 8) = (u32x2){pv[1].z, pv[1].w};
        }
        __syncthreads();
    }
    l += __shfl_xor(l, 32);
    const float inv = 1.0f / l;
#pragma unroll
    for (int dt = 0; dt < 4; ++dt)
#pragma unroll
        for (int ig = 0; ig < 4; ++ig) {
            u32x2 w; w.x = pk2(o[dt][4 * ig] * inv, o[dt][4 * ig + 1] * inv); w.y = pk2(o[dt][4 * ig + 2] * inv, o[dt][4 * ig + 3] * inv);
            *(u32x2*)(orow + 32 * dt + 8 * ig + 4 * h) = w;
        }
}
DI float softmax_shift(const float* ga, const float* gb, int lane) {
    const float ma = wave_max(fmaxf(fabsf(ga[lane]), fabsf(ga[64 + lane])));
    const float mb = wave_max(fmaxf(fabsf(gb[lane]), fabsf(gb[64 + lane])));
    return ma * mb * 11.313708498984761f * 1.4426950408889634f;
}

constexpr int CONV_UT = 37 * 512 * 4;
DI void conv_block(LAS unsigned char* lds, int b, int tb, int tid, const bf16_t* U, const float* cb, const float* lg, const float* lb, bf16_t* CC) {
    const int lane = tid & 63, wave = __builtin_amdgcn_readfirstlane(tid >> 6);
    const int t00 = tb * 32, c0 = 8 * lane;
    LAS unsigned char* ut = lds + CONV_UT;
    __syncthreads();
    for (int i = tid; i < 62 * 64; i += 512) {
        const int row = i >> 6, part = i & 63, ts = t00 - 30 + row;
        u32x4 v = {0u, 0u, 0u, 0u};
        if (ts >= 0) v = *(const u32x4*)(U + ((size_t)b * S_ + ts) * 512 + part * 8);
        *(LAS u32x4*)(ut + row * 1024 + part * 16) = v;
    }
    __syncthreads();
    const LAS float* wl = (const LAS float*)lds + c0;
    const LAS unsigned char* up = ut + (wave * 4) * 1024 + lane * 16;
    float acc[4][8];
#pragma unroll
    for (int tt = 0; tt < 4; ++tt)
#pragma unroll
        for (int k = 0; k < 8; ++k) acc[tt][k] = 0.f;
#pragma unroll 2
    for (int j = 0; j < 34; ++j) {
        float uv[8];
        unpack8(*(const LAS u32x4*)(up + j * 1024), uv);
#pragma unroll
        for (int tt = 0; tt < 4; ++tt) {
            const LAS float* wp = wl + (j - tt + 3) * 512;
            const f32x4 w0 = *(const LAS f32x4*)wp, w1 = *(const LAS f32x4*)(wp + 4);
            acc[tt][0] += w0.x * uv[0]; acc[tt][1] += w0.y * uv[1]; acc[tt][2] += w0.z * uv[2]; acc[tt][3] += w0.w * uv[3];
            acc[tt][4] += w1.x * uv[4]; acc[tt][5] += w1.y * uv[5]; acc[tt][6] += w1.z * uv[6]; acc[tt][7] += w1.w * uv[7];
        }
    }
    float bb[8], gg[8], be[8];
#pragma unroll
    for (int k = 0; k < 8; ++k) { bb[k] = cb[c0 + k]; gg[k] = lg[c0 + k]; be[k] = lb[c0 + k]; }
#pragma unroll
    for (int tt = 0; tt < 4; ++tt) {
        float s = 0.f;
#pragma unroll
        for (int k = 0; k < 8; ++k) { acc[tt][k] += bb[k]; s += acc[tt][k]; }
        const float mean = wave_sum(s) * (1.f / 512.f);
        float q = 0.f;
#pragma unroll
        for (int k = 0; k < 8; ++k) { const float d = acc[tt][k] - mean; q += d * d; }
        const float rstd = rsqrtf(wave_sum(q) * (1.f / 512.f) + EPS_);
        float o[8];
#pragma unroll
        for (int k = 0; k < 8; ++k) { const float y = (acc[tt][k] - mean) * rstd * gg[k] + be[k]; o[k] = y * sigmoidf_(y); }
        *(u32x4*)(CC + ((size_t)b * S_ + t00 + wave * 4 + tt) * 512 + c0) = pack8(o);
    }
}

#define XB_TMO      128
#define XB_XCNT(j)  (256  + 64 * (j))
#define XB_XSUB(j)  (1280 + 64 * (j))
#define XB_XGEN(j)  (2304 + 64 * (j))
#define XB_TOP      3328
#define XB_TOPGEN   3392
#define XCD_BAR_WORDS 3456
#define XB_SPIN_CAP (1u << 18)
DI unsigned xb_ld(unsigned* p)              { return __hip_atomic_load(p, __ATOMIC_RELAXED, __HIP_MEMORY_SCOPE_AGENT); }
DI unsigned xb_add(unsigned* p, unsigned v) { return __hip_atomic_fetch_add(p, v, __ATOMIC_RELAXED, __HIP_MEMORY_SCOPE_AGENT); }
DI unsigned xb_xcc_id() { return (unsigned)__builtin_amdgcn_s_getreg((3 << 11) | 20) & 0xFu; }
#define XB_SPIN(cond, bar) do { unsigned _sp = 0; while (cond) { __builtin_amdgcn_s_sleep(1); \
    if ((++_sp & 255u) == 0u) { if (xb_ld(&(bar)[XB_TMO])) break; if (_sp > XB_SPIN_CAP) { atomicAdd(&(bar)[XB_TMO], 1u); break; } } } } while (0)
struct XcdBarrier { unsigned* bar; unsigned x; volatile LAS unsigned* st; };
DI XcdBarrier xcd_barrier_post(unsigned* bar, volatile LAS unsigned* st) {
    XcdBarrier b; b.bar = bar; b.x = xb_xcc_id(); b.st = st;
    if (threadIdx.x == 0) (void)xb_add(&bar[XB_XCNT(b.x)], 1u);
    return b;
}
DI void xcd_barrier_complete(unsigned* bar, unsigned x, unsigned& nloc, unsigned& nx) {
    const unsigned G = gridDim.x * gridDim.y * gridDim.z;
    unsigned sum, cnt, mine, sp = 0u;
    for (;;) {
        sum = 0u; cnt = 0u; mine = 0u;
#pragma unroll
        for (unsigned j = 0; j < 16; ++j) { const unsigned c = xb_ld(&bar[XB_XCNT(j)]); sum += c; cnt += (c > 0u) ? 1u : 0u; mine = (j == x) ? c : mine; }
        if (sum == G) break;
        __builtin_amdgcn_s_sleep(1);
        if ((++sp & 255u) == 0u) { if (xb_ld(&bar[XB_TMO])) break; if (sp > XB_SPIN_CAP) { atomicAdd(&bar[XB_TMO], 1u); break; } }
    }
    nloc = mine > 0u ? mine : 1u; nx = cnt > 0u ? cnt : 1u;
}
DI void xcd_barrier(const XcdBarrier& b) {
    asm volatile("s_waitcnt vmcnt(0)" ::: "memory");
    __syncthreads();
    if (threadIdx.x == 0) {
        unsigned* bar = b.bar;
        __builtin_amdgcn_s_waitcnt(0);
        unsigned nloc = b.st[0], nx = b.st[1];
        if (nloc == 0u) { xcd_barrier_complete(bar, b.x, nloc, nx); b.st[0] = nloc; b.st[1] = nx; }
        const unsigned old = xb_add(&bar[XB_XSUB(b.x)], 1u);
        const unsigned gen = old / nloc;
        if (old + 1u == (gen + 1u) * nloc) {
            __builtin_amdgcn_fence(__ATOMIC_RELEASE, "agent");
            asm volatile("s_waitcnt vmcnt(0)" ::: "memory");
            const unsigned og = xb_add(&bar[XB_TOP], 1u);
            const unsigned tg = og / nx;
            if (og + 1u == (tg + 1u) * nx) xb_add(&bar[XB_TOPGEN], 1u);
            else XB_SPIN(xb_ld(&bar[XB_TOPGEN]) == tg, bar);
            __builtin_amdgcn_fence(__ATOMIC_ACQUIRE, "agent");
            xb_add(&bar[XB_XGEN(b.x)], 1u);
            asm volatile("s_waitcnt vmcnt(0)" ::: "memory");
        } else {
            XB_SPIN(xb_ld(&bar[XB_XGEN(b.x)]) == gen, bar);
            __builtin_amdgcn_fence(__ATOMIC_ACQUIRE, "agent");
            asm volatile("s_waitcnt vmcnt(0)" ::: "memory");
        }
    }
    __syncthreads();
}
constexpr int XB_LDS_OFF = 147456 - 64;

struct Args { const float* in[25]; float* out; unsigned char* ws; };

#define WT_IN ((bf16_t*)(WSB + WS_WT_IN))
#define WT_AO ((bf16_t*)(WSB + WS_WT_AO))
#define WT_MO ((bf16_t*)(WSB + WS_WT_MO))
#define WT_CO ((bf16_t*)(WSB + WS_WT_CO))
#define WT_OUT ((bf16_t*)(WSB + WS_WT_OUT))
#define WT_UP ((bf16_t*)(WSB + WS_WT_UP))
#define WT_DN ((bf16_t*)(WSB + WS_WT_DN))
#define Gt ((bf16_t*)(WSB + WS_G))
#define P ((bf16_t*)(WSB + WS_P))
#define HID ((bf16_t*)(WSB + WS_HID))
#define OA ((bf16_t*)(WSB + WS_OA))
#define OM ((bf16_t*)(WSB + WS_OM))
#define CC ((bf16_t*)(WSB + WS_CC))
#define A ((bf16_t*)(WSB + WS_A))
#define Q ((bf16_t*)(WSB + WS_Q))
#define IQ ((bf16_t*)(WSB + WS_IQ))
#define MERGED ((bf16_t*)(WSB + WS_MERGED))
#define Kb ((bf16_t*)(WSB + WS_K))
#define VT ((bf16_t*)(WSB + WS_VT))
#define IK ((bf16_t*)(WSB + WS_IK))
#define IW ((float*)(WSB + WS_IW))
#define U ((bf16_t*)(WSB + WS_U))
#define MQ ((bf16_t*)(WSB + WS_MQ))
#define MK ((bf16_t*)(WSB + WS_MK))
#define MVT ((bf16_t*)(WSB + WS_MVT))
#define MASK ((unsigned long long*)(WSB + WS_MASK))
#define MKV ((bf16_t*)(WSB + WS_MKV))
#define norm1_g (args.in[3] + (size_t)LL * D_)
#define w_in (args.in[4] + (size_t)LL * D_ * NIN)
#define q_norm_g (args.in[5] + LL * 128)
#define k_norm_g (args.in[6] + LL * 128)
#define mem_norm_g (args.in[7] + (size_t)LL * D_)
#define w_mem_kv (args.in[8] + (size_t)LL * D_ * 1024)
#define mq_norm_g (args.in[9] + LL * 128)
#define mk_norm_g (args.in[10] + LL * 128)
#define conv_in_b (args.in[11] + LL * 1024)
#define conv_w (args.in[12] + (size_t)LL * 31 * 512)
#define conv_b (args.in[13] + LL * 512)
#define conv_ln_g (args.in[14] + LL * 512)
#define conv_ln_b (args.in[15] + LL * 512)
#define gate_b (args.in[16] + (size_t)LL * NGATE)
#define w_attn_o (args.in[17] + (size_t)LL * 1024 * D_)
#define w_mem_o (args.in[18] + (size_t)LL * 512 * D_)
#define w_conv_o (args.in[19] + (size_t)LL * 512 * D_)
#define conv_o_b (args.in[20] + (size_t)LL * D_)
#define w_out (args.in[21] + (size_t)LL * D_ * D_)
#define norm2_g (args.in[22] + (size_t)LL * D_)
#define w_up (args.in[23] + (size_t)LL * D_ * FF_)
#define w_down (args.in[24] + (size_t)LL * FF_ * D_)
#define xcur (LL == 0 ? x_in : out)
__global__ void __launch_bounds__(512, 2) fwd_megakernel(Args args) {
    extern __shared__ __attribute__((aligned(16))) unsigned char smem[];
    LAS unsigned char* lds = (LAS unsigned char*)smem;
    cg::grid_group grid = cg::this_grid();
    if (threadIdx.x < 16) ((LAS unsigned*)(lds + XB_LDS_OFF))[threadIdx.x] = 0u;
    __syncthreads();
    if (gridDim.y == 0xffffu) grid.sync();
    const XcdBarrier bar = xcd_barrier_post((unsigned*)(args.ws + WS_CTL), (volatile LAS unsigned*)(lds + XB_LDS_OFF));
    const int G = gridDim.x, c = blockIdx.x;
    const int NGW = G * 8;
#define PHASE_IDS const int tid = fresh_tid(), lane = tid & 63, wave = __builtin_amdgcn_readfirstlane(tid >> 6), gw = c * 8 + wave; (void)lane; (void)gw;
    const float* x_in = args.in[0]; const float* mem = args.in[1]; const int* positions = (const int*)args.in[2];
    float* out = args.out;
#define PHASE_L int LL = l; asm volatile("" : "+s"(LL)); unsigned char* WSB = args.ws; asm volatile("" : "+s"(WSB));

    for (int l = 0; l < 2; ++l) {
        for (int rep = 0; rep < REP0; ++rep) {
            PHASE_L
            PHASE_IDS
            LAS float* scr = (LAS float*)(lds + wave * 16640);
            constexpr int I0 = 32 * 164, I1 = 32 * 16, I2 = 16 * 32, I3 = 8 * 32, I4 = 8 * 32, I5 = 32 * 32, I6 = 32 * 128, I7 = 128 * 32;
            constexpr int NIT = I0 + I1 + I2 + I3 + I4 + I5 + I6 + I7;
            for (int it = gw; it < NIT; it += NGW) {
                int r = it;
                if (r < I0) { transpose_item<true>(w_in, 2048, NIN, 164, WT_IN, 0, scr, r, lane); continue; } r -= I0;
                if (r < I1) { transpose_item<false>(w_mem_kv, 2048, 1024, 16, WT_IN, NPAD, scr, r, lane); continue; } r -= I1;
                if (r < I2) { transpose_item<false>(w_attn_o, 1024, 2048, 32, WT_AO, 0, scr, r, lane); continue; } r -= I2;
                if (r < I3) { transpose_item<false>(w_mem_o, 512, 2048, 32, WT_MO, 0, scr, r, lane); continue; } r -= I3;
                if (r < I4) { transpose_item<false>(w_conv_o, 512, 2048, 32, WT_CO, 0, scr, r, lane); continue; } r -= I4;
                if (r < I5) { transpose_item<false>(w_out, 2048, 2048, 32, WT_OUT, 0, scr, r, lane); continue; } r -= I5;
                if (r < I6) { transpose_item<false>(w_up, 2048, 8192, 128, WT_UP, 0, scr, r, lane); continue; } r -= I6;
                transpose_item<false>(w_down, 8192, 2048, 32, WT_DN, 0, scr, r, lane);
            }
            for (int m = gw; m < T_; m += 4 * NGW) {
                if (m + 3 * NGW < T_) rms_rows4_to_bf16(xcur + (size_t)m * D_, (size_t)NGW * D_, norm1_g, A + (size_t)m * D_, (size_t)NGW * D_, lane);
                else for (int mm = m; mm < T_; mm += NGW) rms_row_to_bf16(xcur + (size_t)mm * D_, norm1_g, A + (size_t)mm * D_, lane);
            }
            for (int m = T_ + gw; m < A_ROWS; m += NGW) rms_row_to_bf16(mem + (size_t)(m - T_) * D_, mem_norm_g, A + (size_t)m * D_, lane);
        }
        xcd_barrier(bar);
        for (int rep = 0; rep < REP1; ++rep) {
            PHASE_L
            pg8::Gemm g{A, WT_IN, 2048}; pg8::InOrder S{G, c};
            pg8::EpiIn E{P, Gt, MKV, gate_b};
#ifndef NO_G1
            pg8::gemm_phase(lds, g, S, E);
#endif
        }
        xcd_barrier(bar);
        for (int rep = 0; rep < REP2; ++rep) {
            PHASE_L
            PHASE_IDS
            LAS float* cs = (LAS float*)(lds + wave * 256);
            for (int tok = gw; tok < T_; tok += NGW) {
#ifndef NO_POST
                post_token(tok, lane, cs, P, positions, q_norm_g, k_norm_g, mq_norm_g, conv_in_b, Q, Kb, IQ, IK, IW, U, MQ);
#endif
            }
            for (int it = gw; it < 512; it += NGW) {
                const int bk = it >> 6, tt = it & 63, b = bk >> 1, kvh = bk & 1;
                transpose64x128(P + ((size_t)b * S_ + 64 * tt) * NPROJ + PC_V + kvh * 128, NPROJ, VT + (size_t)bk * 128 * S_ + 64 * tt, S_, lane);
            }
            for (int row = gw; row < MEMROWS; row += NGW) post_memrow(row, lane, MKV, mk_norm_g, MK);
            for (int it = gw; it < 64; it += NGW) {
                const int bh = it >> 2, tt = it & 3, b = bh >> 2, hh = bh & 3;
                transpose64x128(MKV + ((size_t)b * 256 + 64 * tt) * 1024 + 512 + hh * 128, 1024, MVT + (size_t)bh * 128 * 256 + 64 * tt, 256, lane);
            }
        }
        xcd_barrier(bar);
        for (int rep = 0; rep < REP3; ++rep) {
            PHASE_L
            PHASE_IDS
            {
                unsigned* qctr = (unsigned*)(WSB + WS_CTL + 14336) + 64 * LL;
                LAS unsigned* tkt = (LAS unsigned*)(lds + XB_LDS_OFF + 16);
                if (tid == 0) tkt[0] = atomicAdd(qctr, 1u);
                __syncthreads();
                unsigned tk = tkt[0];
                while (tk < 2048u) {
                    unsigned nxt = 0u;
                    if (tid == 0) nxt = atomicAdd(qctr, 1u);
                    const int b = (int)(tk & 3u), tg = 511 - (int)(tk >> 2);
#ifndef NO_IDX
                    idx_rows(lds, b, tg, IQ, IK, IW, MASK);
#endif
                    __syncthreads();
                    if (tid == 0) tkt[0] = nxt;
                    __syncthreads();
                    tk = tkt[0];
                }
            }
            __syncthreads();
            const float c2m = softmax_shift(mq_norm_g, mk_norm_g, lane);
            for (int it = c; it < 256; it += G) {
                const int bh = it >> 4, qb = it & 15, b = bh >> 2, hh = bh & 3;
                const size_t qr = (size_t)b * S_ + qb * 256 + wave * 32 + (lane & 31);
#ifndef NO_MATT
                attn_unit<false>(lds, MQ + qr * 512 + hh * 128, MK + (size_t)b * 256 * 512 + hh * 128, 512, MVT + (size_t)bh * 128 * 256, 256, 4,
                                 nullptr, OM + qr * 512 + hh * 128, 0.08838834764831845f * 1.4426950408889634f, c2m);
#endif
            }
            __syncthreads();
            for (int i = tid; i < 37 * 128; i += 512) {
                const int rowi = i >> 7;
                f32x4 v = {0.f, 0.f, 0.f, 0.f};
                if (rowi >= 3 && rowi <= 33) v = ((const f32x4*)conv_w)[i - 3 * 128];
                ((LAS f32x4*)lds)[i] = v;
            }
            for (int rr = 0; rr < REP3C; ++rr)
            for (int it = c; it < 512; it += G) {
#ifndef NO_CONV
                conv_block(lds, it >> 7, it & 127, tid, U, conv_b, conv_ln_g, conv_ln_b, CC);
#endif
            }
        }
        xcd_barrier(bar);
        for (int rep = 0; rep < REP4; ++rep) {
            PHASE_L
            PHASE_IDS
            const float c2a = softmax_shift(q_norm_g, k_norm_g, lane);
            for (int k = 0; k < (512 + G - 1) / G; ++k) {
                const int it = k * G + c;
                if (it < 512) {
                    const int kk = it / 256, cc = it % 256;
                    const int bk = cc & 7, j = cc >> 3, qb = kk ? (63 - j) : j, b = bk >> 1, kvh = bk & 1;
                    const int gh = wave & 3, half = wave >> 2, hq = kvh * 4 + gh;
                    const int tq = qb * 64 + half * 32 + (lane & 31);
                    const size_t qr = (size_t)b * S_ + tq;
#ifndef NO_ATT
                    attn_unit<true>(lds, Q + qr * 1024 + hq * 128, Kb + (size_t)b * S_ * 256 + kvh * 128, 256, VT + (size_t)bk * 128 * S_, S_, qb + 1,
                                    MASK + (size_t)b * 64 * S_ + tq, OA + qr * 1024 + hq * 128, 0.08838834764831845f * 1.4426950408889634f, c2a);
#endif
                }
            }
        }
        xcd_barrier(bar);
        for (int rep = 0; rep < REP5; ++rep) {
            PHASE_L
            pg8::StaticOrder S; S.init(T_, D_, G, c);
            pg8::EpiMerge E{MERGED, Gt, conv_o_b};
            pg8::merge_phase(lds, OA, OM, CC, WT_AO, WT_MO, WT_CO, S, E);
        }
        xcd_barrier(bar);
        {
            PHASE_L
            pg8::StaticOrder S; S.init(T_, D_, G, c);
            pg8::Gemm g{MERGED, WT_OUT, 2048}; pg8::EpiRes E{xcur, out};
#ifndef NO_G6
 pg8::gemm_phase(lds, g, S, E);
#endif

        }
        xcd_barrier(bar);
        for (int rep = 0; rep < REP7; ++rep) { PHASE_IDS
            PHASE_L
        for (int m = gw; m < T_; m += 4 * NGW) {
            if (m + 3 * NGW < T_) rms_rows4_to_bf16(out + (size_t)m * D_, (size_t)NGW * D_, norm2_g, A + (size_t)m * D_, (size_t)NGW * D_, lane);
            else for (int mm = m; mm < T_; mm += NGW) rms_row_to_bf16(out + (size_t)mm * D_, norm2_g, A + (size_t)mm * D_, lane);
        } }
        xcd_barrier(bar);
        for (int rep = 0; rep < REP8; ++rep) {
            PHASE_L
            pg8::StaticOrder S; S.init(T_, FF_, G, c);
            pg8::Gemm g{A, WT_UP, 2048}; pg8::EpiRelu2 E{HID};
#ifndef NO_G8
 pg8::gemm_phase(lds, g, S, E);
#endif

        }
        xcd_barrier(bar);
        {
            PHASE_L
            pg8::StaticOrder S; S.init(T_, D_, G, c);
            pg8::Gemm g{HID, WT_DN, 8192}; pg8::EpiRes E{out, out};
#ifndef NO_G9
 pg8::gemm_phase(lds, g, S, E);
#endif

        }
        if (l == 0) xcd_barrier(bar);
    }
#ifdef EXTRA_SYNCS
    for (int i = 0; i < EXTRA_SYNCS; ++i) xcd_barrier(bar);
#endif
}

extern "C" void kernel_launch(void* const* d_in, const int* in_sizes, int n_in, void* d_out, int out_size, void* d_ws, size_t ws_size, hipStream_t stream) {
    static int grid_blocks = 0;
    if (grid_blocks == 0) {
        if (n_in != 25 || out_size != T_ * D_ || ws_size < WS_END) { fprintf(stderr, "kernel_launch: unexpected shapes (n_in %d out %d ws %zu)\n", n_in, out_size, ws_size); grid_blocks = -1; return; }
        int dev = 0, cus = 0, per_cu = 0;
        hipGetDevice(&dev);
        hipDeviceGetAttribute(&cus, hipDeviceAttributeMultiprocessorCount, dev);
        if (hipFuncSetAttribute((const void*)fwd_megakernel, hipFuncAttributeMaxDynamicSharedMemorySize, LDS_BYTES) != hipSuccess) { fprintf(stderr, "kernel_launch: hipFuncSetAttribute failed\n"); grid_blocks = -1; return; }
        if (hipOccupancyMaxActiveBlocksPerMultiprocessor(&per_cu, (const void*)fwd_megakernel, 512, LDS_BYTES) != hipSuccess || per_cu < 1) { fprintf(stderr, "kernel_launch: occupancy query gave %d\n", per_cu); per_cu = 1; }
        (void)hipGetLastError();
        grid_blocks = cus * 1;
    }
    if (grid_blocks < 0) return;
    if (hipMemsetAsync((char*)d_ws + WS_CTL, 0, CTL_BYTES, stream) != hipSuccess) { fprintf(stderr, "kernel_launch: memset failed\n"); return; }
    Args a{};
    for (int i = 0; i < 25; ++i) a.in[i] = (const float*)d_in[i];
    a.out = (float*)d_out; a.ws = (unsigned char*)d_ws;
    void* kargs[] = {&a};
    hipError_t e = hipLaunchCooperativeKernel((const void*)fwd_megakernel, dim3(grid_blocks), dim3(512), kargs, LDS_BYTES, stream);
    if (e != hipSuccess) fprintf(stderr, "cooperative launch failed: %s (grid %d)\n", hipGetErrorString(e), grid_blocks);
}
```

```cpp
#include <hip/hip_runtime.h>
#include <hip/hip_cooperative_groups.h>
#include <cstdio>
namespace cg = cooperative_groups;

#define LAS __attribute__((address_space(3)))
#define DI __device__ __forceinline__
typedef unsigned short bf16_t;
typedef short bf16x8 __attribute__((ext_vector_type(8)));
typedef short s16x4 __attribute__((ext_vector_type(4)));
typedef float f32x4 __attribute__((ext_vector_type(4)));
typedef float f32x2 __attribute__((ext_vector_type(2)));
typedef float f32x16 __attribute__((ext_vector_type(16)));
typedef unsigned u32x4 __attribute__((ext_vector_type(4)));
typedef unsigned u32x2 __attribute__((ext_vector_type(2)));
typedef __bf16 bf16x2_t __attribute__((ext_vector_type(2)));

constexpr int NB = 4, S_ = 4096, T_ = NB * S_, D_ = 2048, FF_ = 8192;
constexpr int NIN = 10320, NPAD = 10496, NPROJ = 4352, NGATE = 6144;
constexpr int MEMROWS = NB * 256;
constexpr int A_ROWS = T_ + MEMROWS;
constexpr int BT_ROWS = NPAD + 1024;
constexpr float EPS_ = 1e-6f;
constexpr int PC_Q = 0, PC_K = 1024, PC_V = 1280, PC_IQ = 1536, PC_IK = 2560, PC_IW = 2624, PC_GLU = 2816, PC_MQ = 3840;

constexpr size_t WS_WT_IN = 0;
constexpr size_t WS_WT_AO = WS_WT_IN + (size_t)BT_ROWS * 2048 * 2;
constexpr size_t WS_WT_MO = WS_WT_AO + (size_t)2048 * 1024 * 2;
constexpr size_t WS_WT_CO = WS_WT_MO + (size_t)2048 * 512 * 2;
constexpr size_t WS_WT_OUT = WS_WT_CO + (size_t)2048 * 512 * 2;
constexpr size_t WS_WT_UP = WS_WT_OUT + (size_t)2048 * 2048 * 2;
constexpr size_t WS_WT_DN = WS_WT_UP + (size_t)8192 * 2048 * 2;
constexpr size_t WS_G = WS_WT_DN + (size_t)2048 * 8192 * 2;
constexpr size_t WS_P = WS_G + (size_t)T_ * NGATE * 2;
constexpr size_t WS_HID = WS_G;
constexpr size_t WS_OA = WS_P, WS_OM = WS_OA + (size_t)T_ * 1024 * 2, WS_CC = WS_OM + (size_t)T_ * 512 * 2;
constexpr size_t WS_A = WS_P + (size_t)T_ * NPROJ * 2;
constexpr size_t WS_Q = WS_A, WS_IQ = WS_A + (size_t)T_ * 1024 * 2;
constexpr size_t WS_MERGED = WS_A;
constexpr size_t WS_K = WS_A + (size_t)A_ROWS * 2048 * 2;
constexpr size_t WS_VT = WS_K + (size_t)T_ * 256 * 2;
constexpr size_t WS_IK = WS_VT + (size_t)T_ * 256 * 2;
constexpr size_t WS_IW = WS_IK + (size_t)T_ * 64 * 2;
constexpr size_t WS_U = WS_IW + (size_t)T_ * 16 * 4;
constexpr size_t WS_MQ = WS_U + (size_t)T_ * 512 * 2;
constexpr size_t WS_MK = WS_MQ + (size_t)T_ * 512 * 2;
constexpr size_t WS_MVT = WS_MK + (size_t)MEMROWS * 512 * 2;
constexpr size_t WS_MASK = WS_MVT + (size_t)MEMROWS * 512 * 2;
constexpr size_t WS_MKV = WS_MASK + (size_t)NB * 64 * S_ * 8;
constexpr size_t WS_CTL = WS_MKV + (size_t)MEMROWS * 1024 * 2;
constexpr size_t CTL_BYTES = 16384;
constexpr size_t WS_END = WS_CTL + CTL_BYTES;
static_assert(WS_HID + (size_t)T_ * FF_ * 2 <= WS_A, "hidden overlay");
static_assert(WS_CC + (size_t)T_ * 512 * 2 <= WS_A, "branch outputs inside P");
static_assert(WS_IQ + (size_t)T_ * 1024 * 2 <= WS_K, "q/iq inside A");
static_assert(WS_END <= 676331520ull, "workspace");

constexpr int LDS_BYTES = 147456;
#ifndef REP3A
#define REP3A 1
#endif
#ifndef REP3C
#define REP3C 1
#endif
#ifndef REP1
#define REP1 1
#endif
#ifndef REP8
#define REP8 1
#endif
#ifndef REP5
#define REP5 1
#endif
#ifndef REP0
#define REP0 1
#endif
#ifndef REP2
#define REP2 1
#endif
#ifndef REP3
#define REP3 1
#endif
#ifndef REP4
#define REP4 1
#endif
#ifndef REP7
#define REP7 1
#endif

DI int fresh_tid() { int t = threadIdx.x; asm volatile("" : "+v"(t)); return t; }
DI float bf2f(unsigned short b) { return __uint_as_float(((unsigned)b) << 16); }
DI unsigned pk2(float lo, float hi) { f32x2 v = {lo, hi}; bf16x2_t b = __builtin_convertvector(v, bf16x2_t); return __builtin_bit_cast(unsigned, b); }
DI float wave_sum(float v) {
#pragma unroll
    for (int o = 1; o < 64; o <<= 1) v += __shfl_xor(v, o);
    return v;
}
DI float wave_max(float v) {
#pragma unroll
    for (int o = 1; o < 64; o <<= 1) v = fmaxf(v, __shfl_xor(v, o));
    return v;
}
DI void unpack8(u32x4 w, float* v) {
    v[0] = __uint_as_float(w.x << 16); v[1] = __uint_as_float(w.x & 0xffff0000u);
    v[2] = __uint_as_float(w.y << 16); v[3] = __uint_as_float(w.y & 0xffff0000u);
    v[4] = __uint_as_float(w.z << 16); v[5] = __uint_as_float(w.z & 0xffff0000u);
    v[6] = __uint_as_float(w.w << 16); v[7] = __uint_as_float(w.w & 0xffff0000u);
}
DI u32x4 pack8(const float* v) { u32x4 w; w.x = pk2(v[0], v[1]); w.y = pk2(v[2], v[3]); w.z = pk2(v[4], v[5]); w.w = pk2(v[6], v[7]); return w; }
DI unsigned pack_gate4(float a, float b, float c, float d) {
    unsigned w = 0u;
    w = __builtin_amdgcn_cvt_pk_u8_f32(fmaxf(a * 255.f, 1.f), 0, w); w = __builtin_amdgcn_cvt_pk_u8_f32(fmaxf(b * 255.f, 1.f), 1, w);
    w = __builtin_amdgcn_cvt_pk_u8_f32(fmaxf(c * 255.f, 1.f), 2, w); w = __builtin_amdgcn_cvt_pk_u8_f32(fmaxf(d * 255.f, 1.f), 3, w);
    return w;
}
DI void unpack_gate8(u32x2 w, float* v) {
    v[0] = (float)(w.x & 0xffu); v[1] = (float)((w.x >> 8) & 0xffu); v[2] = (float)((w.x >> 16) & 0xffu); v[3] = (float)(w.x >> 24);
    v[4] = (float)(w.y & 0xffu); v[5] = (float)((w.y >> 8) & 0xffu); v[6] = (float)((w.y >> 16) & 0xffu); v[7] = (float)(w.y >> 24);
}
DI float sigmoidf_(float x) { return __builtin_amdgcn_rcpf(1.0f + __builtin_amdgcn_exp2f(x * -1.4426950408889634f)); }

namespace pg8 {
constexpr int BM = 256, BK = 64, HALF = 128, HTB = HALF * BK * 2, STAGE_BYTES = 8 * HTB, NXCD = 8, WGM = 4;
DI int lds_byte(int r, int c) { const int st = (r >> 4) * 2 + (c >> 5), rr = r & 15, cc = c & 31, ob = rr * 64 + cc * 2; return st * 1024 + (ob ^ (((ob >> 9) & 1) << 5)); }
DI void stage_rc(int b, int& R, int& C) { const int st = b / 1024, sb = b % 1024, swz = sb ^ (((sb >> 9) & 1) << 5); R = (st >> 1) * 16 + swz / 64; C = (st & 1) * 32 + (swz % 64) / 2; }
DI int perm32(int rho) { const int n = rho >> 4, i = rho & 15; return 8 * (i >> 2) + 4 * n + (i & 3); }
struct Unit { int pm, pn; };
struct Gemm { const bf16_t* A; const bf16_t* Bt; int K; };
DI void static_map(int wgid, int nM, int nN, Unit& u) {
    const int nwg = nM * nN;
    { const int q = nwg / NXCD, r = nwg % NXCD, xcd = wgid % NXCD, off = wgid / NXCD; wgid = (xcd < r ? xcd * (q + 1) : r * (q + 1) + (xcd - r) * q) + off; }
    const int nig = WGM * nN, gid = wgid / nig, fm = gid * WGM, gsz = (nM - fm) < WGM ? (nM - fm) : WGM;
    u.pm = fm + ((wgid % nig) % gsz); u.pn = (wgid % nig) / gsz;
}
struct StaticOrder {
    int nM, nN, nwg, G, c;
    DI void init(int M, int N, int G_, int c_) { nM = M / BM; nN = N / BM; nwg = nM * nN; G = G_; c = c_; }
    DI bool next(int i, Unit& u) const { const long L = (long)i * G + c; if (L >= nwg) return false; static_map((int)L, nM, nN, u); return true; }
};
struct InOrder {
    int G, c;
    DI bool next(int i, Unit& u) const {
        const long L = (long)i * G + c;
        if (L < 2624) { static_map((int)L, 64, 41, u); return true; }
        if (L < 2640) { const int e = (int)L - 2624; u.pm = 64 + (e >> 2); u.pn = 41 + (e & 3); return true; }
        return false;
    }
};

template <class Epi, class Sched>
DI void gemm_phase(LAS unsigned char* lds, const Gemm g, const Sched& S, const Epi& E) {
    const int tid = fresh_tid(), wid = __builtin_amdgcn_readfirstlane(tid >> 6), lane = tid & 63, wr = wid >> 2, wc = wid & 3, fr = lane & 15, fq = lane >> 4;
    const int K = g.K, nt = K / BK;
    unsigned voffA[2], voffB[2];
#pragma unroll
    for (int i = 0; i < 2; ++i) { int R, C; stage_rc(tid * 16 + i * 8192, R, C); const int Rb = (R & ~31) + perm32(R & 31);
        voffA[i] = (unsigned)(R * K + C) * 2u; voffB[i] = (unsigned)(Rb * K + C) * 2u; }
    const size_t kstep = (size_t)(BK * 2);
    const size_t hstep = (size_t)HALF * K * 2;
    const size_t tstep = 2 * hstep;
    const unsigned ldsw = (unsigned)wid * 1024u;
    const int aoff = lds_byte(wr * 64 + fr, fq * 8), boff = lds_byte(wc * 32 + fr, fq * 8);
#define PG8_SA(b, h) (((b) * 2 + (h)) * HTB)
#define PG8_SB(b, h) ((4 + (b) * 2 + (h)) * HTB)
#define PG8_STAGE(bufoff, gbase, voff) do { _Pragma("unroll") for (int _i = 0; _i < 2; ++_i) \
        __builtin_amdgcn_global_load_lds((const unsigned*)((const char*)(gbase) + (voff)[_i]), (LAS unsigned*)(lds + (bufoff) + ldsw + _i * 8192), 16, 0, 0); } while (0)
#define PG8_LDA(dst, b, h) do { _Pragma("unroll") for (int m = 0; m < 4; ++m) _Pragma("unroll") for (int k = 0; k < 2; ++k) dst[m][k] = *(const LAS bf16x8*)(lds + PG8_SA(b, h) + aoff + m * 2048 + k * 1024); } while (0)
#define PG8_LDB(dst, b, h) do { _Pragma("unroll") for (int n = 0; n < 2; ++n) _Pragma("unroll") for (int k = 0; k < 2; ++k) dst[n][k] = *(const LAS bf16x8*)(lds + PG8_SB(b, h) + boff + n * 2048 + k * 1024); } while (0)
#define PG8_MMA(ai, bj, At, Bt) do { __builtin_amdgcn_s_setprio(1); _Pragma("unroll") for (int m = 0; m < 4; ++m) _Pragma("unroll") for (int n = 0; n < 2; ++n) _Pragma("unroll") for (int k = 0; k < 2; ++k) \
        acc[ai][bj][m][n] = __builtin_amdgcn_mfma_f32_16x16x32_bf16(Bt[n][k], At[m][k], acc[ai][bj][m][n], 0, 0, 0); __builtin_amdgcn_s_setprio(0); } while (0)
#define PG8_WAIT_V(n) asm volatile("s_waitcnt vmcnt(" #n ")" ::: "memory")
#define PG8_WAIT_L(n) asm volatile("s_waitcnt lgkmcnt(" #n ")" ::: "memory")
#define PG8_BAR __builtin_amdgcn_s_barrier()
#define PG8_SCHED __builtin_amdgcn_sched_barrier(0)
    Unit cur, nxt; int ui = 0;
    if (!S.next(0, cur)) return;
    f32x4 acc[2][2][4][2];
#pragma unroll
    for (int a = 0; a < 2; ++a)
#pragma unroll
        for (int b = 0; b < 2; ++b)
#pragma unroll
            for (int m = 0; m < 4; ++m)
#pragma unroll
                for (int n = 0; n < 2; ++n) acc[a][b][m][n] = (f32x4){0.f, 0.f, 0.f, 0.f};
    bf16x8 At[4][2], B0[2][2], B1[2][2];
    const char* cA = (const char*)g.A + (size_t)cur.pm * tstep; const char* cB = (const char*)g.Bt + (size_t)cur.pn * tstep;
    PG8_STAGE(PG8_SB(0, 0), cB, voffB); PG8_STAGE(PG8_SA(0, 0), cA, voffA); PG8_STAGE(PG8_SB(0, 1), cB + hstep, voffB); PG8_STAGE(PG8_SA(0, 1), cA + hstep, voffA);
    if (wr == 1) PG8_BAR;
    PG8_WAIT_V(4); PG8_BAR;
    PG8_STAGE(PG8_SB(1, 0), cB + kstep, voffB); PG8_STAGE(PG8_SA(1, 0), cA + kstep, voffA); PG8_STAGE(PG8_SB(1, 1), cB + hstep + kstep, voffB);
    PG8_WAIT_V(6); PG8_BAR;
    for (;;) {
        const bool has_next = S.next(ui + 1, nxt);
        const char* nA = has_next ? (const char*)g.A + (size_t)nxt.pm * tstep : cA; const char* nB = has_next ? (const char*)g.Bt + (size_t)nxt.pn * tstep : cB;
        for (int t = 0; t < nt; t += 2) {
            const bool last = (t == nt - 2);
            const char* a1 = cA + (size_t)(t + 1) * kstep;
            const char* a2 = last ? nA : cA + (size_t)(t + 2) * kstep; const char* b2 = last ? nB : cB + (size_t)(t + 2) * kstep;
            const char* a3 = a2 + kstep; const char* b3 = b2 + kstep;
            PG8_LDB(B0, 0, 0); PG8_SCHED; PG8_LDA(At, 0, 0); PG8_STAGE(PG8_SA(1, 1), a1 + hstep, voffA);
            PG8_WAIT_L(8); PG8_BAR; PG8_WAIT_L(0); PG8_MMA(0, 0, At, B0); PG8_BAR; PG8_SCHED;
            PG8_LDB(B1, 0, 1); PG8_STAGE(PG8_SB(0, 0), b2, voffB);
            PG8_BAR; PG8_WAIT_L(0); PG8_MMA(0, 1, At, B1); PG8_BAR;
            PG8_LDA(At, 0, 1); PG8_STAGE(PG8_SA(0, 0), a2, voffA);
            PG8_BAR; PG8_WAIT_L(0); PG8_MMA(1, 0, At, B0); PG8_BAR; PG8_SCHED;
            PG8_STAGE(PG8_SB(0, 1), b2 + hstep, voffB);
            PG8_WAIT_V(6); PG8_BAR; PG8_MMA(1, 1, At, B1); PG8_BAR;
            PG8_LDB(B0, 1, 0); PG8_SCHED; PG8_LDA(At, 1, 0); PG8_STAGE(PG8_SA(0, 1), a2 + hstep, voffA);
            PG8_WAIT_L(8); PG8_BAR; PG8_WAIT_L(0); PG8_MMA(0, 0, At, B0); PG8_BAR; PG8_SCHED;
            PG8_LDB(B1, 1, 1); PG8_STAGE(PG8_SB(1, 0), b3, voffB);
            PG8_BAR; PG8_WAIT_L(0); PG8_MMA(0, 1, At, B1); PG8_BAR;
            PG8_LDA(At, 1, 1); PG8_STAGE(PG8_SA(1, 0), a3, voffA);
            PG8_BAR; PG8_WAIT_L(0); PG8_MMA(1, 0, At, B0); PG8_BAR; PG8_SCHED;
            PG8_STAGE(PG8_SB(1, 1), b3 + hstep, voffB);
            PG8_WAIT_V(6); PG8_BAR; PG8_MMA(1, 1, At, B1); PG8_BAR;
        }
        E(acc, cur, wr, wc, fr, fq);
        if (!has_next) break;
#pragma unroll
        for (int a = 0; a < 2; ++a)
#pragma unroll
            for (int b = 0; b < 2; ++b)
#pragma unroll
                for (int m = 0; m < 4; ++m)
#pragma unroll
                    for (int n = 0; n < 2; ++n) acc[a][b][m][n] = (f32x4){0.f, 0.f, 0.f, 0.f};
        cur = nxt; cA = nA; cB = nB; ++ui;
    }
    PG8_WAIT_V(0);
    if (wr == 0) PG8_BAR;
    PG8_BAR;
#undef PG8_SA
#undef PG8_SB
#undef PG8_STAGE
#undef PG8_LDA
#undef PG8_LDB
#undef PG8_MMA
#undef PG8_WAIT_V
#undef PG8_WAIT_L
#undef PG8_BAR
#undef PG8_SCHED
}

typedef f32x4 AccT[2][2][4][2];
struct EpiIn {
    bf16_t* P; bf16_t* G; bf16_t* MKV; const float* gate_b;
    DI void operator()(const AccT& acc, const Unit& u, int wr, int wc, int fr, int fq) const {
        const int row0 = u.pm * BM + wr * 64 + fr;
        bf16_t* base; int ldc, colt; bool gate = false;
        if (u.pn >= 41) { base = MKV - (size_t)T_ * 1024; ldc = 1024; colt = (u.pn - 41) * BM; }
        else if (u.pn >= 17) { base = G; ldc = NGATE; colt = (u.pn - 17) * BM; gate = true; }
        else { base = P; ldc = NPROJ; colt = u.pn * BM; }
        const int col0 = colt + wc * 32 + 8 * fq;
        f32x4 bv[2][2];
#pragma unroll
        for (int bj = 0; bj < 2; ++bj)
#pragma unroll
            for (int n = 0; n < 2; ++n) bv[bj][n] = gate ? *(const f32x4*)(gate_b + col0 + bj * HALF + 4 * n) : (f32x4){0.f, 0.f, 0.f, 0.f};
#pragma unroll
        for (int ai = 0; ai < 2; ++ai)
#pragma unroll
            for (int m = 0; m < 4; ++m) { bf16_t* rowp = base + (size_t)(row0 + ai * HALF + m * 16) * ldc + col0;
#pragma unroll
                for (int bj = 0; bj < 2; ++bj) { f32x4 v0 = acc[ai][bj][m][0] + bv[bj][0], v1 = acc[ai][bj][m][1] + bv[bj][1];
                    if (gate) {
#pragma unroll
                        for (int j = 0; j < 4; ++j) { v0[j] = sigmoidf_(v0[j]); v1[j] = sigmoidf_(v1[j]); } }
                    if (gate) {
                        u32x2 q; q.x = pack_gate4(v0[0], v0[1], v0[2], v0[3]); q.y = pack_gate4(v1[0], v1[1], v1[2], v1[3]);
                        *(u32x2*)((unsigned char*)G + (size_t)(row0 + ai * HALF + m * 16) * NGATE + col0 + bj * HALF) = q;
                    } else {
                        u32x4 w; w.x = pk2(v0[0], v0[1]); w.y = pk2(v0[2], v0[3]); w.z = pk2(v1[0], v1[1]); w.w = pk2(v1[2], v1[3]);
                        *(u32x4*)(rowp + bj * HALF) = w; } } }
    }
};
template <int MODE> struct EpiGate {
    bf16_t* Mg; const bf16_t* gate; const float* bias;
    DI void operator()(const AccT& acc, const Unit& u, int wr, int wc, int fr, int fq) const {
        const int row0 = u.pm * BM + wr * 64 + fr, col0 = u.pn * BM + wc * 32 + 8 * fq;
        f32x4 bv[2][2];
#pragma unroll
        for (int bj = 0; bj < 2; ++bj)
#pragma unroll
            for (int n = 0; n < 2; ++n) bv[bj][n] = bias ? *(const f32x4*)(bias + col0 + bj * HALF + 4 * n) : (f32x4){0.f, 0.f, 0.f, 0.f};
#pragma unroll
        for (int ai = 0; ai < 2; ++ai)
#pragma unroll
            for (int m = 0; m < 4; ++m) { const size_t r = (size_t)(row0 + ai * HALF + m * 16);
#pragma unroll
                for (int bj = 0; bj < 2; ++bj) {
                    float gv[8], mv[8], o[8];
                    unpack8(*(const u32x4*)(gate + r * NGATE + col0 + bj * HALF), gv);
                    bf16_t* mp = Mg + r * D_ + col0 + bj * HALF;
                    if (MODE) unpack8(*(const u32x4*)mp, mv);
                    const f32x4 v0 = acc[ai][bj][m][0] + bv[bj][0], v1 = acc[ai][bj][m][1] + bv[bj][1];
#pragma unroll
                    for (int j = 0; j < 4; ++j) { o[j] = gv[j] * v0[j] + (MODE ? mv[j] : 0.f); o[4 + j] = gv[4 + j] * v1[j] + (MODE ? mv[4 + j] : 0.f); }
                    *(u32x4*)mp = pack8(o); } }
    }
};
struct EpiRes {
    const float* res; float* out;
    DI void operator()(const AccT& acc, const Unit& u, int wr, int wc, int fr, int fq) const {
        const int row0 = u.pm * BM + wr * 64 + fr, col0 = u.pn * BM + wc * 32 + 8 * fq;
#pragma unroll
        for (int ai = 0; ai < 2; ++ai)
#pragma unroll
            for (int mh = 0; mh < 2; ++mh) {
                f32x4 r[2][2][2];
#pragma unroll
                for (int mm = 0; mm < 2; ++mm) { const size_t off = (size_t)(row0 + ai * HALF + (2 * mh + mm) * 16) * D_ + col0;
#pragma unroll
                    for (int bj = 0; bj < 2; ++bj) { r[mm][bj][0] = *(const f32x4*)(res + off + bj * HALF); r[mm][bj][1] = *(const f32x4*)(res + off + bj * HALF + 4); } }
#pragma unroll
                for (int mm = 0; mm < 2; ++mm) { const int m = 2 * mh + mm; const size_t off = (size_t)(row0 + ai * HALF + m * 16) * D_ + col0;
#pragma unroll
                    for (int bj = 0; bj < 2; ++bj) {
                        *(f32x4*)(out + off + bj * HALF) = r[mm][bj][0] + acc[ai][bj][m][0];
                        *(f32x4*)(out + off + bj * HALF + 4) = r[mm][bj][1] + acc[ai][bj][m][1]; } }
            }
    }
};
struct EpiRelu2 {
    bf16_t* H;
    DI void operator()(const AccT& acc, const Unit& u, int wr, int wc, int fr, int fq) const {
        const int row0 = u.pm * BM + wr * 64 + fr, col0 = u.pn * BM + wc * 32 + 8 * fq;
#pragma unroll
        for (int ai = 0; ai < 2; ++ai)
#pragma unroll
            for (int m = 0; m < 4; ++m) { bf16_t* rowp = H + (size_t)(row0 + ai * HALF + m * 16) * FF_ + col0;
#pragma unroll
                for (int bj = 0; bj < 2; ++bj) { f32x4 v0 = acc[ai][bj][m][0], v1 = acc[ai][bj][m][1];
#pragma unroll
                    for (int j = 0; j < 4; ++j) { const float a = fmaxf(v0[j], 0.f), b = fmaxf(v1[j], 0.f); v0[j] = a * a; v1[j] = b * b; }
                    u32x4 w; w.x = pk2(v0[0], v0[1]); w.y = pk2(v0[2], v0[3]); w.z = pk2(v1[0], v1[1]); w.w = pk2(v1[2], v1[3]);
                    *(u32x4*)(rowp + bj * HALF) = w; } }
    }
};
struct Seg { const char* A; const char* B; int K; int nt; };
struct MergeSrc { const bf16_t* A0; const bf16_t* A1; const bf16_t* A2; const bf16_t* B0; const bf16_t* B1; const bf16_t* B2; };
DI void merge_seg(const bf16_t* a0, const bf16_t* a1, const bf16_t* a2, const bf16_t* b0, const bf16_t* b1, const bf16_t* b2, int pm, int pn, int seg, Seg& o) {
    const int K = seg == 0 ? 1024 : 512;
    const bf16_t* a = seg == 0 ? a0 : (seg == 1 ? a1 : a2); const bf16_t* b = seg == 0 ? b0 : (seg == 1 ? b1 : b2);
    o.A = (const char*)a + (size_t)pm * 256 * K * 2; o.B = (const char*)b + (size_t)pn * 256 * K * 2; o.K = K; o.nt = K / BK;
}
template <class Epi, class Sched>
DI void merge_phase(LAS unsigned char* lds, const bf16_t* a0, const bf16_t* a1, const bf16_t* a2, const bf16_t* b0, const bf16_t* b1, const bf16_t* b2, const Sched& S, const Epi& E) {
    const int tid = fresh_tid(), wid = __builtin_amdgcn_readfirstlane(tid >> 6), lane = tid & 63, wr = wid >> 2, wc = wid & 3, fr = lane & 15, fq = lane >> 4;
    unsigned RA2[2], RB2[2], C2[2];
#pragma unroll
    for (int i = 0; i < 2; ++i) { int R, C; stage_rc(tid * 16 + i * 8192, R, C); const int Rb = (R & ~31) + perm32(R & 31);
        RA2[i] = (unsigned)R * 2u; RB2[i] = (unsigned)Rb * 2u; C2[i] = (unsigned)C * 2u; }
    const size_t kstep = (size_t)(BK * 2);
    const unsigned ldsw = (unsigned)wid * 1024u;
    const int aoff = lds_byte(wr * 64 + fr, fq * 8), boff = lds_byte(wc * 32 + fr, fq * 8);
#define PG8_SA(b, h) (((b) * 2 + (h)) * HTB)
#define PG8_SB(b, h) ((4 + (b) * 2 + (h)) * HTB)
#define PG8_STAGE(bufoff, gbase, RR, KK) do { _Pragma("unroll") for (int _i = 0; _i < 2; ++_i) \
        __builtin_amdgcn_global_load_lds((const unsigned*)((const char*)(gbase) + (RR[_i] * (unsigned)(KK) + C2[_i])), (LAS unsigned*)(lds + (bufoff) + ldsw + _i * 8192), 16, 0, 0); } while (0)
#define PG8_LDA(dst, b, h) do { _Pragma("unroll") for (int m = 0; m < 4; ++m) _Pragma("unroll") for (int k = 0; k < 2; ++k) dst[m][k] = *(const LAS bf16x8*)(lds + PG8_SA(b, h) + aoff + m * 2048 + k * 1024); } while (0)
#define PG8_LDB(dst, b, h) do { _Pragma("unroll") for (int n = 0; n < 2; ++n) _Pragma("unroll") for (int k = 0; k < 2; ++k) dst[n][k] = *(const LAS bf16x8*)(lds + PG8_SB(b, h) + boff + n * 2048 + k * 1024); } while (0)
#define PG8_MMA(ai, bj, At, Bt) do { __builtin_amdgcn_s_setprio(1); _Pragma("unroll") for (int m = 0; m < 4; ++m) _Pragma("unroll") for (int n = 0; n < 2; ++n) _Pragma("unroll") for (int k = 0; k < 2; ++k) \
        acc[ai][bj][m][n] = __builtin_amdgcn_mfma_f32_16x16x32_bf16(Bt[n][k], At[m][k], acc[ai][bj][m][n], 0, 0, 0); __builtin_amdgcn_s_setprio(0); } while (0)
#define PG8_WAIT_V(n) asm volatile("s_waitcnt vmcnt(" #n ")" ::: "memory")
#define PG8_WAIT_L(n) asm volatile("s_waitcnt lgkmcnt(" #n ")" ::: "memory")
#define PG8_BAR __builtin_amdgcn_s_barrier()
#define PG8_SCHED __builtin_amdgcn_sched_barrier(0)
    Unit cu, nu;
    if (!S.next(0, cu)) return;
    Seg cur, nxt; merge_seg(a0, a1, a2, b0, b1, b2, cu.pm, cu.pn, 0, cur);
    f32x4 acc[2][2][4][2];
#pragma unroll
    for (int a = 0; a < 2; ++a)
#pragma unroll
        for (int b = 0; b < 2; ++b)
#pragma unroll
            for (int m = 0; m < 4; ++m)
#pragma unroll
                for (int n = 0; n < 2; ++n) acc[a][b][m][n] = (f32x4){0.f, 0.f, 0.f, 0.f};
    bf16x8 At[4][2], B0[2][2], B1[2][2];
    {
        const char* cA = cur.A; const char* cB = cur.B; const int Kc = cur.K; const size_t hc = (size_t)HALF * Kc * 2;
        PG8_STAGE(PG8_SB(0, 0), cB, RB2, Kc); PG8_STAGE(PG8_SA(0, 0), cA, RA2, Kc); PG8_STAGE(PG8_SB(0, 1), cB + hc, RB2, Kc); PG8_STAGE(PG8_SA(0, 1), cA + hc, RA2, Kc);
        if (wr == 1) PG8_BAR;
        PG8_WAIT_V(4); PG8_BAR;
        PG8_STAGE(PG8_SB(1, 0), cB + kstep, RB2, Kc); PG8_STAGE(PG8_SA(1, 0), cA + kstep, RA2, Kc); PG8_STAGE(PG8_SB(1, 1), cB + hc + kstep, RB2, Kc);
        PG8_WAIT_V(6); PG8_BAR;
    }
#define MRG_KLOOP(CUR, NXT) do { \
        const char* cA = (CUR).A; const char* cB = (CUR).B; const int Kc = (CUR).K, Kn = (NXT).K, nt = (CUR).nt; const size_t hc = (size_t)HALF * Kc * 2; \
        for (int t = 0; t < nt; t += 2) { \
            asm volatile("" : "+v"(C2[0]), "+v"(C2[1])); \
            const bool last = (t == nt - 2); \
            const char* a1 = cA + (size_t)(t + 1) * kstep; \
            const char* a2 = last ? (NXT).A : cA + (size_t)(t + 2) * kstep; const char* b2 = last ? (NXT).B : cB + (size_t)(t + 2) * kstep; \
            const char* a3 = a2 + kstep; const char* b3 = b2 + kstep; \
            const int K2 = last ? Kn : Kc; const size_t h2 = (size_t)HALF * K2 * 2; \
            PG8_LDB(B0, 0, 0); PG8_SCHED; PG8_LDA(At, 0, 0); PG8_STAGE(PG8_SA(1, 1), a1 + hc, RA2, Kc); \
            PG8_WAIT_L(8); PG8_BAR; PG8_WAIT_L(0); PG8_MMA(0, 0, At, B0); PG8_BAR; PG8_SCHED; \
            PG8_LDB(B1, 0, 1); PG8_STAGE(PG8_SB(0, 0), b2, RB2, K2); \
            PG8_BAR; PG8_WAIT_L(0); PG8_MMA(0, 1, At, B1); PG8_BAR; \
            PG8_LDA(At, 0, 1); PG8_STAGE(PG8_SA(0, 0), a2, RA2, K2); \
            PG8_BAR; PG8_WAIT_L(0); PG8_MMA(1, 0, At, B0); PG8_BAR; PG8_SCHED; \
            PG8_STAGE(PG8_SB(0, 1), b2 + h2, RB2, K2); \
            PG8_WAIT_V(6); PG8_BAR; PG8_MMA(1, 1, At, B1); PG8_BAR; \
            PG8_LDB(B0, 1, 0); PG8_SCHED; PG8_LDA(At, 1, 0); PG8_STAGE(PG8_SA(0, 1), a2 + h2, RA2, K2); \
            PG8_WAIT_L(8); PG8_BAR; PG8_WAIT_L(0); PG8_MMA(0, 0, At, B0); PG8_BAR; PG8_SCHED; \
            PG8_LDB(B1, 1, 1); PG8_STAGE(PG8_SB(1, 0), b3, RB2, K2); \
            PG8_BAR; PG8_WAIT_L(0); PG8_MMA(0, 1, At, B1); PG8_BAR; \
            PG8_LDA(At, 1, 1); PG8_STAGE(PG8_SA(1, 0), a3, RA2, K2); \
            PG8_BAR; PG8_WAIT_L(0); PG8_MMA(1, 0, At, B0); PG8_BAR; PG8_SCHED; \
            PG8_STAGE(PG8_SB(1, 1), b3 + h2, RB2, K2); \
            PG8_WAIT_V(6); PG8_BAR; PG8_MMA(1, 1, At, B1); PG8_BAR; \
        } } while (0)
    for (int ui = 0;; ++ui) {
        Seg s1, s2; merge_seg(a0, a1, a2, b0, b1, b2, cu.pm, cu.pn, 1, s1); merge_seg(a0, a1, a2, b0, b1, b2, cu.pm, cu.pn, 2, s2);
        const bool has_next = S.next(ui + 1, nu);
        if (has_next) merge_seg(a0, a1, a2, b0, b1, b2, nu.pm, nu.pn, 0, nxt); else nxt = s2;
        MRG_KLOOP(cur, s1);
        E.mid(acc, cu, 0, wr, wc, fr, fq);
        MRG_KLOOP(s1, s2);
        E.mid(acc, cu, 1, wr, wc, fr, fq);
        MRG_KLOOP(s2, nxt);
        E.fin(acc, cu, wr, wc, fr, fq);
#pragma unroll
        for (int a = 0; a < 2; ++a)
#pragma unroll
            for (int b = 0; b < 2; ++b)
#pragma unroll
                for (int m = 0; m < 4; ++m)
#pragma unroll
                    for (int n = 0; n < 2; ++n) acc[a][b][m][n] = (f32x4){0.f, 0.f, 0.f, 0.f};
        if (!has_next) break;
        cur = nxt; cu = nu;
    }
#undef MRG_KLOOP
    PG8_WAIT_V(0);
    if (wr == 0) PG8_BAR;
    PG8_BAR;
#undef PG8_SA
#undef PG8_SB
#undef PG8_STAGE
#undef PG8_LDA
#undef PG8_LDB
#undef PG8_MMA
#undef PG8_WAIT_V
#undef PG8_WAIT_L
#undef PG8_BAR
#undef PG8_SCHED
}


struct EpiMerge {
    bf16_t* Mg; const bf16_t* G; const float* bias;
    DI void mid(AccT& acc, const Unit& u, int seg, int wr, int wc, int fr, int fq) const {
        const int row0 = u.pm * BM + wr * 64 + fr, col0 = u.pn * BM + wc * 32 + 8 * fq;
        const unsigned char* pa = (const unsigned char*)G + (size_t)row0 * NGATE + seg * 2048 + col0;
#pragma unroll
        for (int ai = 0; ai < 2; ++ai) {
#pragma unroll
            for (int mh = 0; mh < 2; ++mh) {
                u32x2 ra[2][2], rb[2][2];
#pragma unroll
                for (int mm = 0; mm < 2; ++mm)
#pragma unroll
                    for (int bj = 0; bj < 2; ++bj) { const unsigned char* p = pa + (size_t)(mm * 16) * NGATE + bj * HALF; ra[mm][bj] = *(const u32x2*)p; rb[mm][bj] = *(const u32x2*)(p + 2048); }
#pragma unroll
                for (int mm = 0; mm < 2; ++mm)
#pragma unroll
                    for (int bj = 0; bj < 2; ++bj) {
                        float ga[8], gb[8];
                        unpack_gate8(ra[mm][bj], ga); unpack_gate8(rb[mm][bj], gb);
                        const int m = 2 * mh + mm;
#pragma unroll
                        for (int j = 0; j < 4; ++j) { const float r0 = ga[j] * __builtin_amdgcn_rcpf(gb[j]), r1 = ga[4 + j] * __builtin_amdgcn_rcpf(gb[4 + j]);
                            acc[ai][bj][m][0][j] *= r0; acc[ai][bj][m][1][j] *= r1; } }
                pa += (size_t)(mh == 1 ? 96 : 32) * NGATE;
                asm volatile("" : "+v"(pa));
            } }
    }
    DI void fin(const AccT& acc, const Unit& u, int wr, int wc, int fr, int fq) const {
        const int row0 = u.pm * BM + wr * 64 + fr, col0 = u.pn * BM + wc * 32 + 8 * fq;
        const unsigned char* pg = (const unsigned char*)G + (size_t)row0 * NGATE + 4096 + col0;
        bf16_t* pm_ = Mg + (size_t)row0 * D_ + col0;
        f32x4 bv[2][2];
#pragma unroll
        for (int bj = 0; bj < 2; ++bj)
#pragma unroll
            for (int n = 0; n < 2; ++n) bv[bj][n] = *(const f32x4*)(bias + col0 + bj * HALF + 4 * n);
#pragma unroll
        for (int ai = 0; ai < 2; ++ai) {
#pragma unroll
            for (int mh = 0; mh < 2; ++mh) {
                u32x2 rg[2][2];
#pragma unroll
                for (int mm = 0; mm < 2; ++mm)
#pragma unroll
                    for (int bj = 0; bj < 2; ++bj) rg[mm][bj] = *(const u32x2*)(pg + (size_t)(mm * 16) * NGATE + bj * HALF);
#pragma unroll
                for (int mm = 0; mm < 2; ++mm)
#pragma unroll
                    for (int bj = 0; bj < 2; ++bj) {
                        const int m = 2 * mh + mm;
                        float gv[8], o[8];
                        unpack_gate8(rg[mm][bj], gv);
                        const f32x4 v0 = acc[ai][bj][m][0] + bv[bj][0], v1 = acc[ai][bj][m][1] + bv[bj][1];
#pragma unroll
                        for (int j = 0; j < 4; ++j) { o[j] = gv[j] * (1.f / 255.f) * v0[j]; o[4 + j] = gv[4 + j] * (1.f / 255.f) * v1[j]; }
                        *(u32x4*)(pm_ + (size_t)(mm * 16) * D_ + bj * HALF) = pack8(o); }
                pg += (size_t)(mh == 1 ? 96 : 32) * NGATE; pm_ += (size_t)(mh == 1 ? 96 : 32) * D_;
                asm volatile("" : "+v"(pg), "+v"(pm_));
            } }
    }
};
}

template <bool INMAP>
DI void transpose_item(const float* W, int K, int N, int nblk, bf16_t* WT, int row_off, LAS float* scr, int item, int lane) {
    const int kb = item / nblk, nb = item % nblk, k0 = 64 * kb, n0 = 64 * nb;
    const int q = lane & 15, kr = lane >> 4;
    const int np = n0 + 4 * q;
    int ns = np;
    if (INMAP) ns = np < 2640 ? np : (np < 2816 ? -1 : np - 176);
#pragma unroll 16
    for (int i = 0; i < 16; ++i) { const int kk = 4 * i + kr;
        f32x4 v = {0.f, 0.f, 0.f, 0.f};
        if (ns >= 0) v = __builtin_nontemporal_load((const f32x4*)(W + (size_t)(k0 + kk) * N + ns));
        LAS float* d = scr + kk * 65 + 4 * q; d[0] = v.x; d[1] = v.y; d[2] = v.z; d[3] = v.w; }
    asm volatile("s_waitcnt lgkmcnt(0)" ::: "memory");
    const int c = lane & 7;
#pragma unroll
    for (int j = 0; j < 8; ++j) { const int n = (lane >> 3) + 8 * j; const LAS float* s = scr + (8 * c) * 65 + n;
        u32x4 o; o.x = pk2(s[0 * 65], s[1 * 65]); o.y = pk2(s[2 * 65], s[3 * 65]); o.z = pk2(s[4 * 65], s[5 * 65]); o.w = pk2(s[6 * 65], s[7 * 65]);
        *(u32x4*)(WT + (size_t)(row_off + n0 + n) * K + k0 + 8 * c) = o; }
    asm volatile("s_waitcnt lgkmcnt(0)" ::: "memory");
}
DI void rms_row_to_bf16(const float* xrow, const float* g, bf16_t* orow, int lane) {
    const f32x4* xr = (const f32x4*)xrow + lane; const f32x4* gr = (const f32x4*)g + lane;
    f32x4 v[8]; float s = 0.f;
#pragma unroll
    for (int j = 0; j < 8; ++j) { v[j] = xr[64 * j]; s += (v[j].x * v[j].x + v[j].y * v[j].y) + (v[j].z * v[j].z + v[j].w * v[j].w); }
    const float rs = rsqrtf(wave_sum(s) * (1.f / D_) + EPS_);
    u32x2* o8 = (u32x2*)orow + lane;
#pragma unroll
    for (int j = 0; j < 8; ++j) { const f32x4 gg = gr[64 * j]; u32x2 w; w.x = pk2(v[j].x * rs * gg.x, v[j].y * rs * gg.y); w.y = pk2(v[j].z * rs * gg.z, v[j].w * rs * gg.w); o8[64 * j] = w; }
}

DI void rms_rows2_to_bf16(const float* x0, const float* g0, bf16_t* o0, const float* x1, const float* g1, bf16_t* o1, int lane) {
    const f32x4* xr0 = (const f32x4*)x0 + lane; const f32x4* xr1 = (const f32x4*)x1 + lane;
    f32x4 v0[8], v1[8]; float s0 = 0.f, s1 = 0.f;
#pragma unroll
    for (int j = 0; j < 8; ++j) { v0[j] = xr0[64 * j]; v1[j] = xr1[64 * j]; }
#pragma unroll
    for (int j = 0; j < 8; ++j) { s0 += (v0[j].x * v0[j].x + v0[j].y * v0[j].y) + (v0[j].z * v0[j].z + v0[j].w * v0[j].w); s1 += (v1[j].x * v1[j].x + v1[j].y * v1[j].y) + (v1[j].z * v1[j].z + v1[j].w * v1[j].w); }
    const float r0 = rsqrtf(wave_sum(s0) * (1.f / D_) + EPS_), r1 = rsqrtf(wave_sum(s1) * (1.f / D_) + EPS_);
    const f32x4* gr0 = (const f32x4*)g0 + lane; const f32x4* gr1 = (const f32x4*)g1 + lane;
    u32x2* p0 = (u32x2*)o0 + lane; u32x2* p1 = (u32x2*)o1 + lane;
#pragma unroll
    for (int j = 0; j < 8; ++j) { const f32x4 ga = gr0[64 * j], gb = gr1[64 * j]; u32x2 w;
        w.x = pk2(v0[j].x * r0 * ga.x, v0[j].y * r0 * ga.y); w.y = pk2(v0[j].z * r0 * ga.z, v0[j].w * r0 * ga.w); p0[64 * j] = w;
        w.x = pk2(v1[j].x * r1 * gb.x, v1[j].y * r1 * gb.y); w.y = pk2(v1[j].z * r1 * gb.z, v1[j].w * r1 * gb.w); p1[64 * j] = w; }
}
DI void rms_rows4_to_bf16(const float* xb, size_t xstride, const float* g, bf16_t* ob, size_t ostride, int lane) {
    f32x4 v[4][8]; float ss[4];
#pragma unroll
    for (int r = 0; r < 4; ++r)
#pragma unroll
        for (int j = 0; j < 8; ++j) v[r][j] = ((const f32x4*)(xb + r * xstride))[lane + 64 * j];
#pragma unroll
    for (int r = 0; r < 4; ++r) { float s = 0.f;
#pragma unroll
        for (int j = 0; j < 8; ++j) s += (v[r][j].x * v[r][j].x + v[r][j].y * v[r][j].y) + (v[r][j].z * v[r][j].z + v[r][j].w * v[r][j].w);
        ss[r] = rsqrtf(wave_sum(s) * (1.f / D_) + EPS_); }
    const f32x4* gr = (const f32x4*)g + lane;
#pragma unroll
    for (int j = 0; j < 8; ++j) { const f32x4 gg = gr[64 * j];
#pragma unroll
        for (int r = 0; r < 4; ++r) { u32x2 w; w.x = pk2(v[r][j].x * ss[r] * gg.x, v[r][j].y * ss[r] * gg.y); w.y = pk2(v[r][j].z * ss[r] * gg.z, v[r][j].w * ss[r] * gg.w);
            ((u32x2*)(ob + r * ostride))[lane + 64 * j] = w; } }
}
DI void load16(const bf16_t* p, float* v) { unpack8(*(const u32x4*)p, v); unpack8(*(const u32x4*)(p + 8), v + 8); }
DI void store16(bf16_t* p, const float* v) { *(u32x4*)p = pack8(v); *(u32x4*)(p + 8) = pack8(v + 8); }

DI void post_token(int tok, int lane, LAS float* cs  , const bf16_t* P, const int* positions,
                   const float* gq, const float* gk, const float* gmq, const float* cinb,
                   bf16_t* Q, bf16_t* Kb, bf16_t* IQ, bf16_t* IK, float* IW, bf16_t* U, bf16_t* MQ) {
    const bf16_t* prow = P + (size_t)tok * NPROJ;
    const u32x4 rq0 = *(const u32x4*)(prow + PC_Q + 16 * lane), rq1 = *(const u32x4*)(prow + PC_Q + 16 * lane + 8);
    const u32x4 rk0 = *(const u32x4*)(prow + PC_K + 16 * (lane & 15)), rk1 = *(const u32x4*)(prow + PC_K + 16 * (lane & 15) + 8);
    const u32x4 ri0 = *(const u32x4*)(prow + PC_IQ + 16 * lane), ri1 = *(const u32x4*)(prow + PC_IQ + 16 * lane + 8);
    const u32x4 rj0 = *(const u32x4*)(prow + PC_IK + 16 * (lane & 3)), rj1 = *(const u32x4*)(prow + PC_IK + 16 * (lane & 3) + 8);
    const unsigned short rw = prow[PC_IW + (lane & 15)];
    const u32x4 rga = *(const u32x4*)(prow + PC_GLU + 8 * lane), rgg = *(const u32x4*)(prow + PC_GLU + 512 + 8 * lane);
    const u32x4 rm0 = *(const u32x4*)(prow + PC_MQ + 16 * (lane & 31)), rm1 = *(const u32x4*)(prow + PC_MQ + 16 * (lane & 31) + 8);
    const int posv = positions[tok];
    if (lane < 16) {
        const float inv = exp2f(-(float)lane * (1.0f / 16.0f) * 18.931568569324174f);
        const float ang = (float)posv * inv;
        const double xd = (double)ang; const double kq = rint(xd * 0.15915494309189535); const float rf = (float)fma(-kq, 6.283185307179586, xd);
        cs[lane] = __cosf(rf); cs[16 + lane] = __sinf(rf);
    }
    asm volatile("s_waitcnt lgkmcnt(0)" ::: "memory");
    __builtin_amdgcn_wave_barrier();
    float v[16];
    {
        unpack8(rq0, v); unpack8(rq1, v + 8);
        float ss = 0.f;
#pragma unroll
        for (int i = 0; i < 16; ++i) ss += v[i] * v[i];
        ss += __shfl_xor(ss, 1); ss += __shfl_xor(ss, 2); ss += __shfl_xor(ss, 4);
        const float rs = rsqrtf(ss * (1.f / 128.f) + EPS_);
        const int d0 = 16 * (lane & 7);
#pragma unroll
        for (int i = 0; i < 16; ++i) v[i] = v[i] * rs * gq[d0 + i];
        const int sub = lane & 7;
#pragma unroll
        for (int i = 0; i < 16; ++i) { const float oth = __shfl_xor(v[i], 1); const float c = cs[i], s = cs[16 + i];
            if (sub == 0) v[i] = v[i] * c - oth * s; else if (sub == 1) v[i] = v[i] * c + oth * s; }
        store16(Q + (size_t)tok * 1024 + 16 * lane, v);
    }
    {
        const int ln = lane & 15;
        unpack8(rk0, v); unpack8(rk1, v + 8);
        float ss = 0.f;
#pragma unroll
        for (int i = 0; i < 16; ++i) ss += v[i] * v[i];
        ss += __shfl_xor(ss, 1); ss += __shfl_xor(ss, 2); ss += __shfl_xor(ss, 4);
        const float rs = rsqrtf(ss * (1.f / 128.f) + EPS_);
        const int d0 = 16 * (ln & 7);
#pragma unroll
        for (int i = 0; i < 16; ++i) v[i] = v[i] * rs * gk[d0 + i];
        const int sub = ln & 7;
#pragma unroll
        for (int i = 0; i < 16; ++i) { const float oth = __shfl_xor(v[i], 1); const float c = cs[i], s = cs[16 + i];
            if (sub == 0) v[i] = v[i] * c - oth * s; else if (sub == 1) v[i] = v[i] * c + oth * s; }
        if (lane < 16) store16(Kb + (size_t)tok * 256 + 16 * ln, v);
    }
    {
        unpack8(ri0, v); unpack8(ri1, v + 8);
        if ((lane & 3) == 0) {
#pragma unroll
            for (int i = 0; i < 8; ++i) { const float c = cs[2 * i], s = cs[16 + 2 * i]; const float a = v[i], b = v[i + 8]; v[i] = a * c - b * s; v[i + 8] = b * c + a * s; }
        }
        store16(IQ + (size_t)tok * 1024 + 16 * lane, v);
    }
    {
        const int ln = lane & 3;
        unpack8(rj0, v); unpack8(rj1, v + 8);
        if (ln == 0) {
#pragma unroll
            for (int i = 0; i < 8; ++i) { const float c = cs[2 * i], s = cs[16 + 2 * i]; const float a = v[i], b = v[i + 8]; v[i] = a * c - b * s; v[i + 8] = b * c + a * s; }
        }
        if (lane < 4) store16(IK + (size_t)tok * 64 + 16 * ln, v);
    }
    if (lane < 16) IW[(size_t)tok * 16 + lane] = bf2f(rw) * 0.03125f;
    {
        float a[8], gt[8], o[8];
        unpack8(rga, a);
        unpack8(rgg, gt);
#pragma unroll
        for (int i = 0; i < 8; ++i) o[i] = (a[i] + cinb[8 * lane + i]) * sigmoidf_(gt[i] + cinb[512 + 8 * lane + i]);
        *(u32x4*)(U + (size_t)tok * 512 + 8 * lane) = pack8(o);
    }
    {
        const int ln = lane & 31;
        unpack8(rm0, v); unpack8(rm1, v + 8);
        float ss = 0.f;
#pragma unroll
        for (int i = 0; i < 16; ++i) ss += v[i] * v[i];
        ss += __shfl_xor(ss, 1); ss += __shfl_xor(ss, 2); ss += __shfl_xor(ss, 4);
        const float rs = rsqrtf(ss * (1.f / 128.f) + EPS_);
        const int d0 = 16 * (ln & 7);
#pragma unroll
        for (int i = 0; i < 16; ++i) v[i] = v[i] * rs * gmq[d0 + i];
        if (lane < 32) store16(MQ + (size_t)tok * 512 + 16 * ln, v);
    }
    __builtin_amdgcn_wave_barrier();
}
DI void transpose64x128(const bf16_t* src, int pitch, bf16_t* dst, int dpitch, int lane) {
    const bf16_t* sp = src + (size_t)lane * pitch;
    u32x4 wq[16];
#pragma unroll
    for (int c = 0; c < 16; ++c) wq[c] = *(const u32x4*)(sp + 8 * c);
#pragma unroll
    for (int c = 0; c < 16; ++c) {
        const u32x4 w = wq[c];
        bf16_t* dp = dst + (size_t)(8 * c) * dpitch + lane;
        dp[0] = (bf16_t)(w.x & 0xffffu); dp[dpitch] = (bf16_t)(w.x >> 16);
        dp[2 * (size_t)dpitch] = (bf16_t)(w.y & 0xffffu); dp[3 * (size_t)dpitch] = (bf16_t)(w.y >> 16);
        dp[4 * (size_t)dpitch] = (bf16_t)(w.z & 0xffffu); dp[5 * (size_t)dpitch] = (bf16_t)(w.z >> 16);
        dp[6 * (size_t)dpitch] = (bf16_t)(w.w & 0xffffu); dp[7 * (size_t)dpitch] = (bf16_t)(w.w >> 16);
    }
}
DI void post_memrow(int row, int lane, const bf16_t* MKV, const float* gmk, bf16_t* MK) {
    float v[16];
    const int ln = lane & 31;
    load16(MKV + (size_t)row * 1024 + 16 * ln, v);
    float ss = 0.f;
#pragma unroll
    for (int i = 0; i < 16; ++i) ss += v[i] * v[i];
    ss += __shfl_xor(ss, 1); ss += __shfl_xor(ss, 2); ss += __shfl_xor(ss, 4);
    const float rs = rsqrtf(ss * (1.f / 128.f) + EPS_);
    const int d0 = 16 * (ln & 7);
#pragma unroll
    for (int i = 0; i < 16; ++i) v[i] = v[i] * rs * gmk[d0 + i];
    if (lane < 32) store16(MK + (size_t)row * 512 + 16 * ln, v);
}

constexpr int IDX_PITCH = 144, IDX_BUF = 256 * IDX_PITCH;
DI unsigned sortable(float f) { const unsigned b = __float_as_uint(f); return b ^ ((unsigned)((int)b >> 31) | 0x80000000u); }
DI int count_ge8(unsigned cand, unsigned a0, unsigned a1, unsigned a2, unsigned a3, unsigned a4, unsigned a5, unsigned a6, unsigned a7) {
    unsigned long long m0, m1, m2, m3, m4, m5, m6, m7;
    asm("v_cmp_le_u32_e64 %0, %8, %9\n\tv_cmp_le_u32_e64 %1, %8, %10\n\tv_cmp_le_u32_e64 %2, %8, %11\n\tv_cmp_le_u32_e64 %3, %8, %12\n\t"
        "v_cmp_le_u32_e64 %4, %8, %13\n\tv_cmp_le_u32_e64 %5, %8, %14\n\tv_cmp_le_u32_e64 %6, %8, %15\n\tv_cmp_le_u32_e64 %7, %8, %16"
        : "=&s"(m0), "=&s"(m1), "=&s"(m2), "=&s"(m3), "=&s"(m4), "=&s"(m5), "=&s"(m6), "=&s"(m7)
        : "s"(cand), "v"(a0), "v"(a1), "v"(a2), "v"(a3), "v"(a4), "v"(a5), "v"(a6), "v"(a7));
    return (__builtin_popcountll(m0) + __builtin_popcountll(m1)) + (__builtin_popcountll(m2) + __builtin_popcountll(m3)) +
           (__builtin_popcountll(m4) + __builtin_popcountll(m5)) + (__builtin_popcountll(m6) + __builtin_popcountll(m7));
}
DI float relu1(float x) { const int b = (int)__float_as_uint(x); return __uint_as_float((unsigned)(b > 0 ? b : 0)); }
typedef unsigned u32x2s __attribute__((ext_vector_type(2)));
DI float swap16_add(float a, float b) { const u32x2s r = __builtin_amdgcn_permlane16_swap(__float_as_uint(a), __float_as_uint(b), false, false); return __uint_as_float(r.x) + __uint_as_float(r.y); }
DI float swap32_add(float a, float b) { const u32x2s r = __builtin_amdgcn_permlane32_swap(__float_as_uint(a), __float_as_uint(b), false, false); return __uint_as_float(r.x) + __uint_as_float(r.y); }
DI void idx_rows(LAS unsigned char* lds, int b, int tg, const bf16_t* IQ, const bf16_t* IK, const float* IW, unsigned long long* maskT) {
    const int tid = fresh_tid(), lane = tid & 63, wave = __builtin_amdgcn_readfirstlane(tid >> 6);
    const int g = lane >> 4, c16 = lane & 15;
    const int tb = tg * 8; const size_t rowb = (size_t)b * S_ + tb;
    const int ngrp = (tb + 7) / 64 + 1;
    LAS unsigned* stab = (LAS unsigned*)lds;
    {
        bf16x8 a0[8], a1[8]; f32x4 wv[8];
#pragma unroll
        for (int j = 0; j < 8; ++j) {
            a0[j] = *(const bf16x8*)(IQ + (rowb + j) * 1024 + c16 * 64 + g * 8);
            a1[j] = *(const bf16x8*)(IQ + (rowb + j) * 1024 + c16 * 64 + 32 + g * 8);
            wv[j] = *(const f32x4*)(IW + (rowb + j) * 16 + 4 * g);
        }
        const bf16_t* ikl = IK + (size_t)b * S_ * 64 + c16 * 64 + g * 8;
        bf16x8 bA[4][2], bB[4][2];
#define IDX_LOADG(dst, grp_) do { _Pragma("unroll") for (int tt = 0; tt < 4; ++tt) { const bf16_t* p_ = ikl + (size_t)(64 * (grp_) + 16 * tt) * 64; dst[tt][0] = *(const bf16x8*)p_; dst[tt][1] = *(const bf16x8*)(p_ + 32); } } while (0)
#define IDX_COMPUTE(src, grp_) do { _Pragma("unroll") for (int j = 0; j < 8; ++j) { \
            f32x4 acc[4]; \
            _Pragma("unroll") for (int tt = 0; tt < 4; ++tt) acc[tt] = __builtin_amdgcn_mfma_f32_16x16x32_bf16(a0[j], src[tt][0], (f32x4){0.f, 0.f, 0.f, 0.f}, 0, 0, 0); \
            _Pragma("unroll") for (int tt = 0; tt < 4; ++tt) acc[tt] = __builtin_amdgcn_mfma_f32_16x16x32_bf16(a1[j], src[tt][1], acc[tt], 0, 0, 0); \
            float v[4]; \
            _Pragma("unroll") for (int tt = 0; tt < 4; ++tt) { const f32x2 r01 = {relu1(acc[tt][0]), relu1(acc[tt][1])}, r23 = {relu1(acc[tt][2]), relu1(acc[tt][3])}; \
                const f32x2 w01 = {wv[j][0], wv[j][1]}, w23 = {wv[j][2], wv[j][3]}; const f32x2 p = w01 * r01 + w23 * r23; v[tt] = p.x + p.y; } \
            const float x01 = swap16_add(v[0], v[1]); const float x23 = swap16_add(v[2], v[3]); const float z = swap32_add(x01, x23); \
            const int key = 64 * (grp_) + lane; \
            stab[j * 4096 + key] = key <= tb + j ? sortable(z) : 0u; } } while (0)
        __syncthreads();
        if (wave < ngrp) IDX_LOADG(bA, wave);
        for (int grp = wave; grp < ngrp; grp += 16) {
            if (grp + 8 < ngrp) IDX_LOADG(bB, grp + 8);
            IDX_COMPUTE(bA, grp);
            if (grp + 8 < ngrp) {
                if (grp + 16 < ngrp) IDX_LOADG(bA, grp + 16);
                IDX_COMPUTE(bB, grp + 8);
            }
        }
#undef IDX_LOADG
#undef IDX_COMPUTE
    }
    __syncthreads();
    const int t = tb + wave;
    unsigned sc[64];
#pragma unroll
    for (int i8 = 0; i8 < 8; ++i8) {
        if (8 * i8 <= (t >> 6)) {
#pragma unroll
            for (int ii = 0; ii < 8; ++ii) sc[8 * i8 + ii] = (8 * i8 + ii) < ngrp ? stab[wave * 4096 + 64 * (8 * i8 + ii) + lane] : 0u;
        } else {
#pragma unroll
            for (int ii = 0; ii < 8; ++ii) sc[8 * i8 + ii] = 0u;
        }
    }
    const int imax = t >> 6;
    const bool all = (t + 1) <= 256;
    unsigned th = 0u;
    bool exact = false;
    if (!all) {
        for (int bit = 31; bit >= 0; --bit) {
            const unsigned cand = th | (1u << bit);
            int cnt = 0;
#pragma unroll
            for (int i8 = 0; i8 < 8; ++i8) {
                if (8 * i8 <= imax) cnt += count_ge8(cand, sc[8 * i8], sc[8 * i8 + 1], sc[8 * i8 + 2], sc[8 * i8 + 3], sc[8 * i8 + 4], sc[8 * i8 + 5], sc[8 * i8 + 6], sc[8 * i8 + 7]);
            }
            if (cnt >= 256) { th = cand; if (cnt == 256) { exact = true; break; } }
        }
    }
    int need = 0;
    if (!all) {
        if (exact) need = 8192;
        else {
            int cgt = 0;
#pragma unroll
            for (int i8 = 0; i8 < 8; ++i8) {
                if (8 * i8 <= imax) {
#pragma unroll
                    for (int i = 0; i < 8; ++i) cgt += __builtin_popcountll(__ballot(sc[8 * i8 + i] > th));
                }
            }
            need = 256 - cgt;
        }
    }
    unsigned mlo = 0u, mhi = 0u;
    if (all || exact) {
        const unsigned thr = all ? 1u : th;
#pragma unroll
        for (int i8 = 0; i8 < 8; ++i8) {
            if (8 * i8 <= imax) {
#pragma unroll
                for (int ii = 0; ii < 8; ++ii) {
                    const int i = 8 * i8 + ii;
                    const unsigned long long word = __ballot(sc[i] >= thr);
                    if (lane == i) { mlo = (unsigned)word; mhi = (unsigned)(word >> 32); }
                }
            }
        }
    } else {
#pragma unroll
        for (int i8 = 0; i8 < 8; ++i8) {
            if (8 * i8 <= imax) {
#pragma unroll
                for (int ii = 0; ii < 8; ++ii) {
                    const int i = 8 * i8 + ii;
                    const unsigned long long gt = __ballot(sc[i] > th);
                    unsigned long long eq = __ballot(sc[i] == th);
                    if (need > 0 && eq != 0ull) {
                        int cq = __builtin_popcountll(eq);
                        while (cq > need) { eq &= ~(1ull << (63 - __builtin_clzll(eq))); --cq; }
                        need -= cq;
                    } else eq = 0ull;
                    const unsigned long long word = gt | eq;
                    if (lane == i) { mlo = (unsigned)word; mhi = (unsigned)(word >> 32); }
                }
            }
        }
    }
    const unsigned long long myword = ((unsigned long long)mhi << 32) | mlo;
    if (lane <= imax) maskT[((size_t)b * 64 + lane) * S_ + t] = myword;
}

constexpr int AK_PITCH = 272, AV_PITCH = 136, AK_BYTES = 64 * AK_PITCH, AV_BYTES = 128 * AV_PITCH, ABUF = AK_BYTES + AV_BYTES;
template <bool MASK>
DI void attn_unit(LAS unsigned char* lds, const bf16_t* qrow, const bf16_t* kbase, int kpitch, const bf16_t* vtbase, int vtpitch, int ntiles,
                  const unsigned long long* maskp, bf16_t* orow, float c1, float c2) {
    const int tid = fresh_tid(), lane = tid & 63, r = lane & 31, h = lane >> 5;
    bf16x8 qf[8];
#pragma unroll
    for (int ks = 0; ks < 8; ++ks) qf[ks] = *(const bf16x8*)(qrow + 16 * ks + 8 * h);
    f32x16 o[4];
#pragma unroll
    for (int d = 0; d < 4; ++d)
#pragma unroll
        for (int i = 0; i < 16; ++i) o[d][i] = 0.f;
    float l = 0.f;
    u32x4 pk[2], pv[2];
    const int ke0 = tid, ke1 = tid + 512;
    const bf16_t* kg0 = kbase + (size_t)(ke0 >> 4) * kpitch + (ke0 & 15) * 8; const bf16_t* kg1 = kbase + (size_t)(ke1 >> 4) * kpitch + (ke1 & 15) * 8;
    const int kl0 = (ke0 >> 4) * AK_PITCH + (ke0 & 15) * 16, kl1 = (ke1 >> 4) * AK_PITCH + (ke1 & 15) * 16;
    const bf16_t* vg0 = vtbase + (size_t)(ke0 >> 3) * vtpitch + (ke0 & 7) * 8; const bf16_t* vg1 = vtbase + (size_t)(ke1 >> 3) * vtpitch + (ke1 & 7) * 8;
    const int vl0 = AK_BYTES + (ke0 >> 3) * AV_PITCH + (ke0 & 7) * 16, vl1 = AK_BYTES + (ke1 >> 3) * AV_PITCH + (ke1 & 7) * 16;
    pk[0] = *(const u32x4*)kg0; pk[1] = *(const u32x4*)kg1; pv[0] = *(const u32x4*)vg0; pv[1] = *(const u32x4*)vg1;
    {
        LAS unsigned char* nb = lds;
        *(LAS u32x4*)(nb + kl0) = pk[0]; *(LAS u32x4*)(nb + kl1) = pk[1];
        *(LAS u32x2*)(nb + vl0) = (u32x2){pv[0].x, pv[0].y}; *(LAS u32x2*)(nb + vl0 + 8) = (u32x2){pv[0].z, pv[0].w};
        *(LAS u32x2*)(nb + vl1) = (u32x2){pv[1].x, pv[1].y}; *(LAS u32x2*)(nb + vl1 + 8) = (u32x2){pv[1].z, pv[1].w};
    }
    unsigned long long mw_next = ~0ull;
    if (MASK) mw_next = maskp[0];
    __syncthreads();
    for (int kt = 0; kt < ntiles; ++kt) {
        const bool more = kt + 1 < ntiles;
        if (more) {
            const size_t ko = (size_t)(kt + 1) * 64 * kpitch; const int vo = (kt + 1) * 64;
            pk[0] = *(const u32x4*)(kg0 + ko); pk[1] = *(const u32x4*)(kg1 + ko); pv[0] = *(const u32x4*)(vg0 + vo); pv[1] = *(const u32x4*)(vg1 + vo);
        }
        const unsigned long long mw = mw_next;
        if (MASK && more) mw_next = maskp[(size_t)(kt + 1) * S_];
        LAS unsigned char* buf = lds + (kt & 1) * ABUF;
        f32x16 xs[2];
#pragma unroll
        for (int sub = 0; sub < 2; ++sub) {
#pragma unroll
            for (int i = 0; i < 16; ++i) xs[sub][i] = 0.f;
            __builtin_amdgcn_s_setprio(1);
#pragma unroll
            for (int ks = 0; ks < 8; ++ks) {
                const bf16x8 a = *(const LAS bf16x8*)(buf + (32 * sub + r) * AK_PITCH + ks * 32 + h * 16);
                xs[sub] = __builtin_amdgcn_mfma_f32_32x32x16_bf16(a, qf[ks], xs[sub], 0, 0, 0);
            }
            __builtin_amdgcn_s_setprio(0);
        }
#pragma unroll
        for (int sub = 0; sub < 2; ++sub) {
            const unsigned mws = ((unsigned)(mw >> (32 * sub))) >> (4 * h);
            float pe[16];
#pragma unroll
            for (int i = 0; i < 16; ++i) {
                float p = __builtin_amdgcn_exp2f(xs[sub][i] * c1 - c2);
                if (MASK) { const int m = __builtin_amdgcn_sbfe((int)mws, (i & 3) + 8 * (i >> 2), 1); p = __uint_as_float(__float_as_uint(p) & (unsigned)m); }
                l += p; pe[i] = p;
            }
            u32x4 p0, p1;
            p0.x = pk2(pe[0], pe[1]); p0.y = pk2(pe[2], pe[3]); p0.z = pk2(pe[4], pe[5]); p0.w = pk2(pe[6], pe[7]);
            p1.x = pk2(pe[8], pe[9]); p1.y = pk2(pe[10], pe[11]); p1.z = pk2(pe[12], pe[13]); p1.w = pk2(pe[14], pe[15]);
            const bf16x8 pb0 = __builtin_bit_cast(bf16x8, p0), pb1 = __builtin_bit_cast(bf16x8, p1);
#pragma unroll
            for (int dt = 0; dt < 4; ++dt) {
                const LAS unsigned char* vp = buf + AK_BYTES + (32 * dt + r) * AV_PITCH + (32 * sub + 4 * h) * 2;
                const s16x4 lo0 = *(const LAS s16x4*)(vp), hi0 = *(const LAS s16x4*)(vp + 16);
                const s16x4 lo1 = *(const LAS s16x4*)(vp + 32), hi1 = *(const LAS s16x4*)(vp + 48);
                const bf16x8 va0 = __builtin_shufflevector(lo0, hi0, 0, 1, 2, 3, 4, 5, 6, 7);
                const bf16x8 va1 = __builtin_shufflevector(lo1, hi1, 0, 1, 2, 3, 4, 5, 6, 7);
                o[dt] = __builtin_amdgcn_mfma_f32_32x32x16_bf16(va0, pb0, o[dt], 0, 0, 0);
                o[dt] = __builtin_amdgcn_mfma_f32_32x32x16_bf16(va1, pb1, o[dt], 0, 0, 0);
            }
        }
        if (more) {
            LAS unsigned char* nb = lds + ((kt + 1) & 1) * ABUF;
            *(LAS u32x4*)(nb + kl0) = pk[0]; *(LAS u32x4*)(nb + kl1) = pk[1];
            *(LAS u32x2*)(nb + vl0) = (u32x2){pv[0].x, pv[0].y}; *(LAS u32x2*)(nb + vl0 + 8) = (u32x2){pv[0].z, pv[0].w};
            *(LAS u32x2*)(nb + vl1) = (u32x2){pv[1].x, pv[1].y}; *(LAS u32x2*)(nb + vl1 + 8) = (u32x2){pv[1].z, pv[1].w};
        }
        __syncthreads();
    }
    l += __shfl_xor(l, 32);
    const float inv = 1.0f / l;
#pragma unroll
    for (int dt = 0; dt < 4; ++dt)
#pragma unroll
        for (int ig = 0; ig < 4; ++ig) {
            u32x2 w; w.x = pk2(o[dt][4 * ig] * inv, o[dt][4 * ig + 1] * inv); w.y = pk2(o[dt][4 * ig + 2] * inv, o[dt][4 * ig + 3] * inv);
            *(u32x2*)(orow + 32 * dt + 8 * ig + 4 * h) = w;
        }
}
DI float softmax_shift(const float* ga, const float* gb, int lane) {
    const float ma = wave_max(fmaxf(fabsf(ga[lane]), fabsf(ga[64 + lane])));
    const float mb = wave_max(fmaxf(fabsf(gb[lane]), fabsf(gb[64 + lane])));
    return ma * mb * 11.313708498984761f * 1.4426950408889634f;
}

constexpr int CONV_UT = 37 * 512 * 4;
DI void conv_block(LAS unsigned char* lds, int b, int tb, int tid, const bf16_t* U, const float* cb, const float* lg, const float* lb, bf16_t* CC) {
    const int lane = tid & 63, wave = __builtin_amdgcn_readfirstlane(tid >> 6);
    const int t00 = tb * 32, c0 = 8 * lane;
    LAS unsigned char* ut = lds + CONV_UT;
    __syncthreads();
    for (int i = tid; i < 62 * 64; i += 512) {
        const int row = i >> 6, part = i & 63, ts = t00 - 30 + row;
        u32x4 v = {0u, 0u, 0u, 0u};
        if (ts >= 0) v = *(const u32x4*)(U + ((size_t)b * S_ + ts) * 512 + part * 8);
        *(LAS u32x4*)(ut + row * 1024 + part * 16) = v;
    }
    __syncthreads();
    const LAS float* wl = (const LAS float*)lds + c0;
    const LAS unsigned char* up = ut + (wave * 4) * 1024 + lane * 16;
    float acc[4][8];
#pragma unroll
    for (int tt = 0; tt < 4; ++tt)
#pragma unroll
        for (int k = 0; k < 8; ++k) acc[tt][k] = 0.f;
#pragma unroll 2
    for (int j = 0; j < 34; ++j) {
        float uv[8];
        unpack8(*(const LAS u32x4*)(up + j * 1024), uv);
#pragma unroll
        for (int tt = 0; tt < 4; ++tt) {
            const LAS float* wp = wl + (j - tt + 3) * 512;
            const f32x4 w0 = *(const LAS f32x4*)wp, w1 = *(const LAS f32x4*)(wp + 4);
            acc[tt][0] += w0.x * uv[0]; acc[tt][1] += w0.y * uv[1]; acc[tt][2] += w0.z * uv[2]; acc[tt][3] += w0.w * uv[3];
            acc[tt][4] += w1.x * uv[4]; acc[tt][5] += w1.y * uv[5]; acc[tt][6] += w1.z * uv[6]; acc[tt][7] += w1.w * uv[7];
        }
    }
    float bb[8], gg[8], be[8];
#pragma unroll
    for (int k = 0; k < 8; ++k) { bb[k] = cb[c0 + k]; gg[k] = lg[c0 + k]; be[k] = lb[c0 + k]; }
#pragma unroll
    for (int tt = 0; tt < 4; ++tt) {
        float s = 0.f;
#pragma unroll
        for (int k = 0; k < 8; ++k) { acc[tt][k] += bb[k]; s += acc[tt][k]; }
        const float mean = wave_sum(s) * (1.f / 512.f);
        float q = 0.f;
#pragma unroll
        for (int k = 0; k < 8; ++k) { const float d = acc[tt][k] - mean; q += d * d; }
        const float rstd = rsqrtf(wave_sum(q) * (1.f / 512.f) + EPS_);
        float o[8];
#pragma unroll
        for (int k = 0; k < 8; ++k) { const float y = (acc[tt][k] - mean) * rstd * gg[k] + be[k]; o[k] = y * sigmoidf_(y); }
        *(u32x4*)(CC + ((size_t)b * S_ + t00 + wave * 4 + tt) * 512 + c0) = pack8(o);
    }
}

#define XB_TMO      128
#define XB_XCNT(j)  (256  + 64 * (j))
#define XB_XSUB(j)  (1280 + 64 * (j))
#define XB_XGEN(j)  (2304 + 64 * (j))
#define XB_TOP      3328
#define XB_TOPGEN   3392
#define XCD_BAR_WORDS 3456
#define XB_SPIN_CAP (1u << 18)
DI unsigned xb_ld(unsigned* p)              { return __hip_atomic_load(p, __ATOMIC_RELAXED, __HIP_MEMORY_SCOPE_AGENT); }
DI unsigned xb_add(unsigned* p, unsigned v) { return __hip_atomic_fetch_add(p, v, __ATOMIC_RELAXED, __HIP_MEMORY_SCOPE_AGENT); }
DI unsigned xb_xcc_id() { return (unsigned)__builtin_amdgcn_s_getreg((3 << 11) | 20) & 0xFu; }
#define XB_SPIN(cond, bar) do { unsigned _sp = 0; while (cond) { __builtin_amdgcn_s_sleep(1); \
    if ((++_sp & 255u) == 0u) { if (xb_ld(&(bar)[XB_TMO])) break; if (_sp > XB_SPIN_CAP) { atomicAdd(&(bar)[XB_TMO], 1u); break; } } } } while (0)
struct XcdBarrier { unsigned* bar; unsigned x; volatile LAS unsigned* st; };
DI XcdBarrier xcd_barrier_post(unsigned* bar, volatile LAS unsigned* st) {
    XcdBarrier b; b.bar = bar; b.x = xb_xcc_id(); b.st = st;
    if (threadIdx.x == 0) (void)xb_add(&bar[XB_XCNT(b.x)], 1u);
    return b;
}
DI void xcd_barrier_complete(unsigned* bar, unsigned x, unsigned& nloc, unsigned& nx) {
    const unsigned G = gridDim.x * gridDim.y * gridDim.z;
    unsigned sum, cnt, mine, sp = 0u;
    for (;;) {
        sum = 0u; cnt = 0u; mine = 0u;
#pragma unroll
        for (unsigned j = 0; j < 16; ++j) { const unsigned c = xb_ld(&bar[XB_XCNT(j)]); sum += c; cnt += (c > 0u) ? 1u : 0u; mine = (j == x) ? c : mine; }
        if (sum == G) break;
        __builtin_amdgcn_s_sleep(1);
        if ((++sp & 255u) == 0u) { if (xb_ld(&bar[XB_TMO])) break; if (sp > XB_SPIN_CAP) { atomicAdd(&bar[XB_TMO], 1u); break; } }
    }
    nloc = mine > 0u ? mine : 1u; nx = cnt > 0u ? cnt : 1u;
}
DI void xcd_barrier(const XcdBarrier& b) {
    asm volatile("s_waitcnt vmcnt(0)" ::: "memory");
    __syncthreads();
    if (threadIdx.x == 0) {
        unsigned* bar = b.bar;
        __builtin_amdgcn_s_waitcnt(0);
        unsigned nloc = b.st[0], nx = b.st[1];
        if (nloc == 0u) { xcd_barrier_complete(bar, b.x, nloc, nx); b.st[0] = nloc; b.st[1] = nx; }
        const unsigned old = xb_add(&bar[XB_XSUB(b.x)], 1u);
        const unsigned gen = old / nloc;
        if (old + 1u == (gen + 1u) * nloc) {
            __builtin_amdgcn_fence(__ATOMIC_RELEASE, "agent");
            asm volatile("s_waitcnt vmcnt(0)" ::: "memory");
            const unsigned og = xb_add(&bar[XB_TOP], 1u);
            const unsigned tg = og / nx;
            if (og + 1u == (tg + 1u) * nx) xb_add(&bar[XB_TOPGEN], 1u);
            else XB_SPIN(xb_ld(&bar[XB_TOPGEN]) == tg, bar);
            __builtin_amdgcn_fence(__ATOMIC_ACQUIRE, "agent");
            xb_add(&bar[XB_XGEN(b.x)], 1u);
            asm volatile("s_waitcnt vmcnt(0)" ::: "memory");
        } else {
            XB_SPIN(xb_ld(&bar[XB_XGEN(b.x)]) == gen, bar);
            __builtin_amdgcn_fence(__ATOMIC_ACQUIRE, "agent");
            asm volatile("s_waitcnt vmcnt(0)" ::: "memory");
        }
    }
    __syncthreads();
}
constexpr int XB_LDS_OFF = 147456 - 64;

struct Args { const float* in[25]; float* out; unsigned char* ws; };

#define WT_IN ((bf16_t*)(WSB + WS_WT_IN))
#define WT_AO ((bf16_t*)(WSB + WS_WT_AO))
#define WT_MO ((bf16_t*)(WSB + WS_WT_MO))
#define WT_CO ((bf16_t*)(WSB + WS_WT_CO))
#define WT_OUT ((bf16_t*)(WSB + WS_WT_OUT))
#define WT_UP ((bf16_t*)(WSB + WS_WT_UP))
#define WT_DN ((bf16_t*)(WSB + WS_WT_DN))
#define Gt ((bf16_t*)(WSB + WS_G))
#define P ((bf16_t*)(WSB + WS_P))
#define HID ((bf16_t*)(WSB + WS_HID))
#define OA ((bf16_t*)(WSB + WS_OA))
#define OM ((bf16_t*)(WSB + WS_OM))
#define CC ((bf16_t*)(WSB + WS_CC))
#define A ((bf16_t*)(WSB + WS_A))
#define Q ((bf16_t*)(WSB + WS_Q))
#define IQ ((bf16_t*)(WSB + WS_IQ))
#define MERGED ((bf16_t*)(WSB + WS_MERGED))
#define Kb ((bf16_t*)(WSB + WS_K))
#define VT ((bf16_t*)(WSB + WS_VT))
#define IK ((bf16_t*)(WSB + WS_IK))
#define IW ((float*)(WSB + WS_IW))
#define U ((bf16_t*)(WSB + WS_U))
#define MQ ((bf16_t*)(WSB + WS_MQ))
#define MK ((bf16_t*)(WSB + WS_MK))
#define MVT ((bf16_t*)(WSB + WS_MVT))
#define MASK ((unsigned long long*)(WSB + WS_MASK))
#define MKV ((bf16_t*)(WSB + WS_MKV))
#define norm1_g (args.in[3] + (size_t)LL * D_)
#define w_in (args.in[4] + (size_t)LL * D_ * NIN)
#define q_norm_g (args.in[5] + LL * 128)
#define k_norm_g (args.in[6] + LL * 128)
#define mem_norm_g (args.in[7] + (size_t)LL * D_)
#define w_mem_kv (args.in[8] + (size_t)LL * D_ * 1024)
#define mq_norm_g (args.in[9] + LL * 128)
#define mk_norm_g (args.in[10] + LL * 128)
#define conv_in_b (args.in[11] + LL * 1024)
#define conv_w (args.in[12] + (size_t)LL * 31 * 512)
#define conv_b (args.in[13] + LL * 512)
#define conv_ln_g (args.in[14] + LL * 512)
#define conv_ln_b (args.in[15] + LL * 512)
#define gate_b (args.in[16] + (size_t)LL * NGATE)
#define w_attn_o (args.in[17] + (size_t)LL * 1024 * D_)
#define w_mem_o (args.in[18] + (size_t)LL * 512 * D_)
#define w_conv_o (args.in[19] + (size_t)LL * 512 * D_)
#define conv_o_b (args.in[20] + (size_t)LL * D_)
#define w_out (args.in[21] + (size_t)LL * D_ * D_)
#define norm2_g (args.in[22] + (size_t)LL * D_)
#define w_up (args.in[23] + (size_t)LL * D_ * FF_)
#define w_down (args.in[24] + (size_t)LL * FF_ * D_)
#define xcur (LL == 0 ? x_in : out)
__global__ void __launch_bounds__(512, 2) fwd_megakernel(Args args) {
    extern __shared__ __attribute__((aligned(16))) unsigned char smem[];
    LAS unsigned char* lds = (LAS unsigned char*)smem;
    cg::grid_group grid = cg::this_grid();
    if (threadIdx.x < 16) ((LAS unsigned*)(lds + XB_LDS_OFF))[threadIdx.x] = 0u;
    __syncthreads();
    if (gridDim.y == 0xffffu) grid.sync();
    const XcdBarrier bar = xcd_barrier_post((unsigned*)(args.ws + WS_CTL), (volatile LAS unsigned*)(lds + XB_LDS_OFF));
    const int G = gridDim.x, c = blockIdx.x;
    const int NGW = G * 8;
#define PHASE_IDS const int tid = fresh_tid(), lane = tid & 63, wave = __builtin_amdgcn_readfirstlane(tid >> 6), gw = c * 8 + wave; (void)lane; (void)gw;
    const float* x_in = args.in[0]; const float* mem = args.in[1]; const int* positions = (const int*)args.in[2];
    float* out = args.out;
#define PHASE_L int LL = l; asm volatile("" : "+s"(LL)); unsigned char* WSB = args.ws; asm volatile("" : "+s"(WSB));

    for (int l = 0; l < 2; ++l) {
        for (int rep = 0; rep < REP0; ++rep) {
            PHASE_L
            PHASE_IDS
            LAS float* scr = (LAS float*)(lds + wave * 16640);
            constexpr int I0 = 32 * 164, I1 = 32 * 16, I2 = 16 * 32, I3 = 8 * 32, I4 = 8 * 32, I5 = 32 * 32, I6 = 32 * 128, I7 = 128 * 32;
            constexpr int NIT = I0 + I1 + I2 + I3 + I4 + I5 + I6 + I7;
            for (int it = gw; it < NIT; it += NGW) {
                int r = it;
                if (r < I0) { transpose_item<true>(w_in, 2048, NIN, 164, WT_IN, 0, scr, r, lane); continue; } r -= I0;
                if (r < I1) { transpose_item<false>(w_mem_kv, 2048, 1024, 16, WT_IN, NPAD, scr, r, lane); continue; } r -= I1;
                if (r < I2) { transpose_item<false>(w_attn_o, 1024, 2048, 32, WT_AO, 0, scr, r, lane); continue; } r -= I2;
                if (r < I3) { transpose_item<false>(w_mem_o, 512, 2048, 32, WT_MO, 0, scr, r, lane); continue; } r -= I3;
                if (r < I4) { transpose_item<false>(w_conv_o, 512, 2048, 32, WT_CO, 0, scr, r, lane); continue; } r -= I4;
                if (r < I5) { transpose_item<false>(w_out, 2048, 2048, 32, WT_OUT, 0, scr, r, lane); continue; } r -= I5;
                if (r < I6) { transpose_item<false>(w_up, 2048, 8192, 128, WT_UP, 0, scr, r, lane); continue; } r -= I6;
                transpose_item<false>(w_down, 8192, 2048, 32, WT_DN, 0, scr, r, lane);
            }
            for (int m = gw; m < T_; m += 4 * NGW) {
                if (m + 3 * NGW < T_) rms_rows4_to_bf16(xcur + (size_t)m * D_, (size_t)NGW * D_, norm1_g, A + (size_t)m * D_, (size_t)NGW * D_, lane);
                else for (int mm = m; mm < T_; mm += NGW) rms_row_to_bf16(xcur + (size_t)mm * D_, norm1_g, A + (size_t)mm * D_, lane);
            }
            for (int m = T_ + gw; m < A_ROWS; m += NGW) rms_row_to_bf16(mem + (size_t)(m - T_) * D_, mem_norm_g, A + (size_t)m * D_, lane);
        }
        xcd_barrier(bar);
        for (int rep = 0; rep < REP1; ++rep) {
            PHASE_L
            pg8::Gemm g{A, WT_IN, 2048}; pg8::InOrder S{G, c};
            pg8::EpiIn E{P, Gt, MKV, gate_b};
#ifndef NO_G1
            pg8::gemm_phase(lds, g, S, E);
#endif
        }
        xcd_barrier(bar);
        for (int rep = 0; rep < REP2; ++rep) {
            PHASE_L
            PHASE_IDS
            LAS float* cs = (LAS float*)(lds + wave * 256);
            for (int tok = gw; tok < T_; tok += NGW) {
#ifndef NO_POST
                post_token(tok, lane, cs, P, positions, q_norm_g, k_norm_g, mq_norm_g, conv_in_b, Q, Kb, IQ, IK, IW, U, MQ);
#endif
            }
            for (int it = gw; it < 512; it += NGW) {
                const int bk = it >> 6, tt = it & 63, b = bk >> 1, kvh = bk & 1;
                transpose64x128(P + ((size_t)b * S_ + 64 * tt) * NPROJ + PC_V + kvh * 128, NPROJ, VT + (size_t)bk * 128 * S_ + 64 * tt, S_, lane);
            }
            for (int row = gw; row < MEMROWS; row += NGW) post_memrow(row, lane, MKV, mk_norm_g, MK);
            for (int it = gw; it < 64; it += NGW) {
                const int bh = it >> 2, tt = it & 3, b = bh >> 2, hh = bh & 3;
                transpose64x128(MKV + ((size_t)b * 256 + 64 * tt) * 1024 + 512 + hh * 128, 1024, MVT + (size_t)bh * 128 * 256 + 64 * tt, 256, lane);
            }
        }
        xcd_barrier(bar);
        for (int rep = 0; rep < REP3; ++rep) {
            PHASE_L
            PHASE_IDS
            __syncthreads();
            const float c2m = softmax_shift(mq_norm_g, mk_norm_g, lane);
            for (int it = c; it < 256; it += G) {
                const int bh = it >> 4, qb = it & 15, b = bh >> 2, hh = bh & 3;
                const size_t qr = (size_t)b * S_ + qb * 256 + wave * 32 + (lane & 31);
#ifndef NO_MATT
                attn_unit<false>(lds, MQ + qr * 512 + hh * 128, MK + (size_t)b * 256 * 512 + hh * 128, 512, MVT + (size_t)bh * 128 * 256, 256, 4,
                                 nullptr, OM + qr * 512 + hh * 128, 0.08838834764831845f * 1.4426950408889634f, c2m);
#endif
            }
            __syncthreads();
            for (int i = tid; i < 37 * 128; i += 512) {
                const int rowi = i >> 7;
                f32x4 v = {0.f, 0.f, 0.f, 0.f};
                if (rowi >= 3 && rowi <= 33) v = ((const f32x4*)conv_w)[i - 3 * 128];
                ((LAS f32x4*)lds)[i] = v;
            }
            for (int rr = 0; rr < REP3C; ++rr)
            for (int it = c; it < 512; it += G) {
#ifndef NO_CONV
                conv_block(lds, it >> 7, it & 127, tid, U, conv_b, conv_ln_g, conv_ln_b, CC);
#endif
            }
            __syncthreads();
            {
                unsigned* qctr = (unsigned*)(WSB + WS_CTL + 14336) + 64 * LL;
                LAS unsigned* tkt = (LAS unsigned*)(lds + XB_LDS_OFF + 16);
                if (tid == 0) tkt[0] = atomicAdd(qctr, 1u);
                __syncthreads();
                unsigned tk = tkt[0];
                while (tk < 2048u) {
                    unsigned nxt = 0u;
                    if (tid == 0) nxt = atomicAdd(qctr, 1u);
                    const int b = (int)(tk & 3u), tg = 511 - (int)(tk >> 2);
#ifndef NO_IDX
                    idx_rows(lds, b, tg, IQ, IK, IW, MASK);
#endif
                    __syncthreads();
                    if (tid == 0) tkt[0] = nxt;
                    __syncthreads();
                    tk = tkt[0];
                }
            }
        }
        xcd_barrier(bar);
        for (int rep = 0; rep < REP4; ++rep) {
            PHASE_L
            PHASE_IDS
            const float c2a = softmax_shift(q_norm_g, k_norm_g, lane);
            for (int k = 0; k < (512 + G - 1) / G; ++k) {
                const int it = k * G + c;
                if (it < 512) {
                    const int kk = it / 256, cc = it % 256;
                    const int bk = cc & 7, j = cc >> 3, qb = kk ? (63 - j) : j, b = bk >> 1, kvh = bk & 1;
                    const int gh = wave & 3, half = wave >> 2, hq = kvh * 4 + gh;
                    const int tq = qb * 64 + half * 32 + (lane & 31);
                    const size_t qr = (size_t)b * S_ + tq;
#ifndef NO_ATT
                    attn_unit<true>(lds, Q + qr * 1024 + hq * 128, Kb + (size_t)b * S_ * 256 + kvh * 128, 256, VT + (size_t)bk * 128 * S_, S_, qb + 1,
                                    MASK + (size_t)b * 64 * S_ + tq, OA + qr * 1024 + hq * 128, 0.08838834764831845f * 1.4426950408889634f, c2a);
#endif
                }
            }
        }
        xcd_barrier(bar);
        for (int rep = 0; rep < REP5; ++rep) {
            PHASE_L
            pg8::StaticOrder S; S.init(T_, D_, G, c);
            pg8::EpiMerge E{MERGED, Gt, conv_o_b};
            pg8::merge_phase(lds, OA, OM, CC, WT_AO, WT_MO, WT_CO, S, E);
        }
        xcd_barrier(bar);
        {
            PHASE_L
            pg8::StaticOrder S; S.init(T_, D_, G, c);
            pg8::Gemm g{MERGED, WT_OUT, 2048}; pg8::EpiRes E{xcur, out};
#ifndef NO_G6
 pg8::gemm_phase(lds, g, S, E);
#endif

        }
        xcd_barrier(bar);
        for (int rep = 0; rep < REP7; ++rep) { PHASE_IDS
            PHASE_L
        for (int m = gw; m < T_; m += 4 * NGW) {
            if (m + 3 * NGW < T_) rms_rows4_to_bf16(out + (size_t)m * D_, (size_t)NGW * D_, norm2_g, A + (size_t)m * D_, (size_t)NGW * D_, lane);
            else for (int mm = m; mm < T_; mm += NGW) rms_row_to_bf16(out + (size_t)mm * D_, norm2_g, A + (size_t)mm * D_, lane);
        } }
        xcd_barrier(bar);
        for (int rep = 0; rep < REP8; ++rep) {
            PHASE_L
            pg8::StaticOrder S; S.init(T_, FF_, G, c);
            pg8::Gemm g{A, WT_UP, 2048}; pg8::EpiRelu2 E{HID};
#ifndef NO_G8
 pg8::gemm_phase(lds, g, S, E);
#endif

        }
        xcd_barrier(bar);
        {
            PHASE_L
            pg8::StaticOrder S; S.init(T_, D_, G, c);
            pg8::Gemm g{HID, WT_DN, 8192}; pg8::EpiRes E{out, out};
#ifndef NO_G9
 pg8::gemm_phase(lds, g, S, E);
#endif

        }
        if (l == 0) xcd_barrier(bar);
    }
#ifdef EXTRA_SYNCS
    for (int i = 0; i < EXTRA_SYNCS; ++i) xcd_barrier(bar);
#endif
}

extern "C" void kernel_launch(void* const* d_in, const int* in_sizes, int n_in, void* d_out, int out_size, void* d_ws, size_t ws_size, hipStream_t stream) {
    static int grid_blocks = 0;
    if (grid_blocks == 0) {
        if (n_in != 25 || out_size != T_ * D_ || ws_size < WS_END) { fprintf(stderr, "kernel_launch: unexpected shapes (n_in %d out %d ws %zu)\n", n_in, out_size, ws_size); grid_blocks = -1; return; }
        int dev = 0, cus = 0, per_cu = 0;
        hipGetDevice(&dev);
        hipDeviceGetAttribute(&cus, hipDeviceAttributeMultiprocessorCount, dev);
        if (hipFuncSetAttribute((const void*)fwd_megakernel, hipFuncAttributeMaxDynamicSharedMemorySize, LDS_BYTES) != hipSuccess) { fprintf(stderr, "kernel_launch: hipFuncSetAttribute failed\n"); grid_blocks = -1; return; }
        if (hipOccupancyMaxActiveBlocksPerMultiprocessor(&per_cu, (const void*)fwd_megakernel, 512, LDS_BYTES) != hipSuccess || per_cu < 1) { fprintf(stderr, "kernel_launch: occupancy query gave %d\n", per_cu); per_cu = 1; }
        (void)hipGetLastError();
        grid_blocks = cus * 1;
    }
    if (grid_blocks < 0) return;
    if (hipMemsetAsync((char*)d_ws + WS_CTL, 0, CTL_BYTES, stream) != hipSuccess) { fprintf(stderr, "kernel_launch: memset failed\n"); return; }
    Args a{};
    for (int i = 0; i < 25; ++i) a.in[i] = (const float*)d_in[i];
    a.out = (float*)d_out; a.ws = (unsigned char*)d_ws;
    void* kargs[] = {&a};
    hipError_t e = hipLaunchCooperativeKernel((const void*)fwd_megakernel, dim3(grid_blocks), dim3(512), kargs, LDS_BYTES, stream);
    if (e != hipSuccess) fprintf(stderr, "cooperative launch failed: %s (grid %d)\n", hipGetErrorString(e), grid_blocks);
}
```
